# Optimizing an MI355X kernel written in HIP

```python
import jax, jax.numpy as jnp
from jax import lax
import numpy as np

D_MODEL = 1024
BATCH = 2
SEQ = 16384
DEPTH = 2
DEC_BATCH = 4
DEC_SEQ = 4096
PAST_LEN = 128

GRID_W = 64
N_MIXERS = 2
N_MLA_LAYERS = (DEPTH + 1) // 2
N_NA_LAYERS = DEPTH // 2
MLA_HEADS = 16
Q_LORA = 384
KV_LORA = 256
QK_NOPE = 128
QK_ROPE = 64
V_HEAD = 128
ROPE_THETA = 10000.0
Q_BLOCK = 128
NA_HEADS = 16
NA_HEAD_DIM = D_MODEL // NA_HEADS
NA_KH = 8
NA_KW = 16
D_FF = 4 * D_MODEL
EPS = 1e-6

kernel_name = "hybrid_mla_natten_encoder"


def rms_norm(x, g):
    xf = x.astype(jnp.float32)
    y = xf * lax.rsqrt(jnp.mean(xf * xf, axis=-1, keepdims=True) + EPS)
    return (y * g.astype(jnp.float32)).astype(x.dtype)


def rope_tables(s, dtype):
    inv = ROPE_THETA ** (-jnp.arange(0, QK_ROPE, 2, dtype=jnp.float32) / QK_ROPE)
    ang = jnp.arange(s, dtype=jnp.float32)[:, None] * inv[None, :]
    return jnp.cos(ang).astype(dtype), jnp.sin(ang).astype(dtype)


def apply_rope(x, cos, sin):
    x1, x2 = jnp.split(x, 2, axis=-1)
    return jnp.concatenate([x1 * cos - x2 * sin, x1 * sin + x2 * cos], axis=-1)


def mla(x, w_dq, q_norm, w_uq, w_dkv, kv_norm, w_ukv, w_o):
    b, s, _ = x.shape
    cos, sin = rope_tables(s, x.dtype)
    c_q = rms_norm(x @ w_dq, q_norm)
    q = (c_q @ w_uq).reshape(b, s, MLA_HEADS, QK_NOPE + QK_ROPE)
    q_nope = q[..., :QK_NOPE]
    q_rope = apply_rope(q[..., QK_NOPE:], cos[:, None], sin[:, None])
    kv_a = x @ w_dkv
    c_kv = rms_norm(kv_a[..., :KV_LORA], kv_norm)
    k_rope = apply_rope(kv_a[..., KV_LORA:], cos, sin)
    kv = (c_kv @ w_ukv).reshape(b, s, MLA_HEADS, QK_NOPE + V_HEAD)
    k_nope, v = kv[..., :QK_NOPE], kv[..., QK_NOPE:]
    scale = (QK_NOPE + QK_ROPE) ** -0.5
    nb = s // Q_BLOCK

    def q_block(args):
        qn, qr = args
        sc = jnp.einsum('bqhd,bkhd->bhqk', qn, k_nope) + jnp.einsum('bqhd,bkd->bhqk', qr, k_rope)
        p = jax.nn.softmax(sc.astype(jnp.float32) * scale, axis=-1).astype(v.dtype)
        return jnp.einsum('bhqk,bkhd->bqhd', p, v)

    def to_blocks(t):
        return jnp.moveaxis(t.reshape(b, nb, Q_BLOCK, *t.shape[2:]), 1, 0)

    o = lax.map(q_block, (to_blocks(q_nope), to_blocks(q_rope)))
    o = jnp.moveaxis(o, 0, 1).reshape(b, s, MLA_HEADS * V_HEAD)
    return o @ w_o


def neighbourhood_attention(x, w_qkv, rpb, w_o):
    b, s, _ = x.shape
    rows = s // GRID_W
    kh = min(NA_KH, rows)
    qkv = (x @ w_qkv).reshape(b, rows, GRID_W, 3, NA_HEADS, NA_HEAD_DIM)
    q, k, v = qkv[:, :, :, 0], qkv[:, :, :, 1], qkv[:, :, :, 2]
    cols = np.arange(GRID_W)
    col_start = np.clip(cols - NA_KW // 2, 0, GRID_W - NA_KW)
    col_idx_np = col_start[:, None] + np.arange(NA_KW)[None, :]
    col_idx = jnp.asarray(col_idx_np, dtype=jnp.int32)
    rel_col = jnp.asarray(col_idx_np - cols[:, None] + NA_KW - 1, dtype=jnp.int32)
    scale = NA_HEAD_DIM ** -0.5

    def row_block(args):
        r, q_r = args
        r0 = jnp.clip(r - kh // 2, 0, rows - kh)
        k_rows = lax.dynamic_slice_in_dim(k, r0, kh, axis=1)
        v_rows = lax.dynamic_slice_in_dim(v, r0, kh, axis=1)
        k_win = k_rows[:, :, col_idx]
        v_win = v_rows[:, :, col_idx]
        rel_row = r0 + jnp.arange(kh, dtype=jnp.int32) - r + NA_KH - 1
        bias = rpb[:, rel_row[None, :, None], rel_col[:, None, :]]
        sc = (jnp.einsum('bqhd,biqjhd->bhqij', q_r, k_win).astype(jnp.float32) * scale
              + bias.astype(jnp.float32)[None])
        p = jax.nn.softmax(sc.reshape(b, NA_HEADS, GRID_W, kh * NA_KW), axis=-1)
        p = p.reshape(sc.shape).astype(v.dtype)
        return jnp.einsum('bhqij,biqjhd->bqhd', p, v_win)

    o = lax.map(row_block, (jnp.arange(rows, dtype=jnp.int32), jnp.moveaxis(q, 1, 0)))
    o = jnp.moveaxis(o, 0, 1).reshape(b, s, NA_HEADS * NA_HEAD_DIM)
    return o @ w_o


def sq_relu_mlp(x, w1, w2):
    h = jax.nn.relu(x @ w1)
    return (h * h) @ w2


def trunk(x, attn_norm, mlp_norm, final_norm, mla_w_dq, mla_q_norm, mla_w_uq, mla_w_dkv,
          mla_kv_norm, mla_w_ukv, mla_w_o, na_w_qkv, na_rpb, na_w_o, mlp_w1, mlp_w2):
    for i in range(DEPTH):
        h = rms_norm(x, attn_norm[i])
        j = i // N_MIXERS
        if i % N_MIXERS == 0:
            h = mla(h, mla_w_dq[j], mla_q_norm[j], mla_w_uq[j], mla_w_dkv[j],
                    mla_kv_norm[j], mla_w_ukv[j], mla_w_o[j])
        else:
            h = neighbourhood_attention(h, na_w_qkv[j], na_rpb[j], na_w_o[j])
        x = x + h
        x = x + sq_relu_mlp(rms_norm(x, mlp_norm[i]), mlp_w1[i], mlp_w2[i])
    return rms_norm(x, final_norm)


def setup_inputs(seed: int = 0) -> dict:
    key = jax.random.key(seed)
    ks = jax.random.split(key, 20)
    f32 = jnp.float32

    def nrm(k, shape, scale):
        return jax.random.normal(k, shape, f32) * scale

    def gain(k, shape):
        return 1.0 + 0.01 * jax.random.normal(k, shape, f32)

    return {
        "x_prompt": jax.random.normal(ks[0], (BATCH, SEQ, D_MODEL), f32),
        "x_sample": jax.random.normal(ks[1], (DEC_BATCH, DEC_SEQ, D_MODEL), f32),
        "attn_norm": gain(ks[2], (DEPTH, D_MODEL)),
        "mlp_norm": gain(ks[3], (DEPTH, D_MODEL)),
        "final_norm": gain(ks[4], (D_MODEL,)),
        "mla_w_dq": nrm(ks[5], (N_MLA_LAYERS, D_MODEL, Q_LORA), D_MODEL ** -0.5),
        "mla_q_norm": gain(ks[6], (N_MLA_LAYERS, Q_LORA)),
        "mla_w_uq": nrm(ks[7], (N_MLA_LAYERS, Q_LORA, MLA_HEADS * (QK_NOPE + QK_ROPE)), Q_LORA ** -0.5),
        "mla_w_dkv": nrm(ks[8], (N_MLA_LAYERS, D_MODEL, KV_LORA + QK_ROPE), D_MODEL ** -0.5),
        "mla_kv_norm": gain(ks[9], (N_MLA_LAYERS, KV_LORA)),
        "mla_w_ukv": nrm(ks[10], (N_MLA_LAYERS, KV_LORA, MLA_HEADS * (QK_NOPE + V_HEAD)), KV_LORA ** -0.5),
        "mla_w_o": nrm(ks[11], (N_MLA_LAYERS, MLA_HEADS * V_HEAD, D_MODEL), (MLA_HEADS * V_HEAD) ** -0.5),
        "na_w_qkv": nrm(ks[12], (N_NA_LAYERS, D_MODEL, 3 * NA_HEADS * NA_HEAD_DIM), D_MODEL ** -0.5),
        "na_rpb": nrm(ks[13], (N_NA_LAYERS, NA_HEADS, 2 * NA_KH - 1, 2 * NA_KW - 1), 0.02),
        "na_w_o": nrm(ks[14], (N_NA_LAYERS, NA_HEADS * NA_HEAD_DIM, D_MODEL), (NA_HEADS * NA_HEAD_DIM) ** -0.5),
        "mlp_w1": nrm(ks[15], (DEPTH, D_MODEL, D_FF), D_MODEL ** -0.5),
        "mlp_w2": nrm(ks[16], (DEPTH, D_FF, D_MODEL), D_FF ** -0.5),
    }


def reference(x_prompt, x_sample, attn_norm, mlp_norm, final_norm, mla_w_dq, mla_q_norm, mla_w_uq,
              mla_w_dkv, mla_kv_norm, mla_w_ukv, mla_w_o, na_w_qkv, na_rpb, na_w_o, mlp_w1, mlp_w2):
    y_prompt = trunk(x_prompt, attn_norm, mlp_norm, final_norm, mla_w_dq, mla_q_norm, mla_w_uq,
                     mla_w_dkv, mla_kv_norm, mla_w_ukv, mla_w_o, na_w_qkv, na_rpb, na_w_o, mlp_w1, mlp_w2)
    y_sample = trunk(x_sample, attn_norm, mlp_norm, final_norm, mla_w_dq, mla_q_norm, mla_w_uq,
                     mla_w_dkv, mla_kv_norm, mla_w_ukv, mla_w_o, na_w_qkv, na_rpb, na_w_o, mlp_w1, mlp_w2)
    return (y_prompt, y_sample)
```

```cpp
#include <hip/hip_runtime.h>
#include <hip/hip_cooperative_groups.h>
#include <cstdio>
#include <cstdint>
namespace cg = cooperative_groups;

typedef unsigned short u16;
using bf16x8 = __attribute__((ext_vector_type(8))) short;
using s16x4  = __attribute__((ext_vector_type(4))) short;
using f32x16 = __attribute__((ext_vector_type(16))) float;
using f32x4  = __attribute__((ext_vector_type(4))) float;
using u32x4  = __attribute__((ext_vector_type(4))) unsigned;
using u32x2  = __attribute__((ext_vector_type(2))) unsigned;
#define DI __device__ __forceinline__
#define SBAR() __builtin_amdgcn_sched_barrier(0)
#define MFMA32(a, b, c) __builtin_amdgcn_mfma_f32_32x32x16_bf16((a), (b), (c), 0, 0, 0)

constexpr int DM = 1024, TP = 32768, TS = 16384, TT = 49152, CH = 16384;
constexpr int NTHR = 512;
constexpr float EPS = 1e-6f;
constexpr size_t MiB = 1048576;
constexpr size_t W_DQKV = 0, W_UQ = 1572864, W_UKV = 3932160, W_O = 6029312, W_NAQKV = 10223616, W_NAO = 16515072, W_W1 = 18612224, W_W2 = 35389440;
constexpr size_t WS_ROPE = 50 * MiB, WS_A = 54 * MiB, WS_B = 150 * MiB, WS_CQ = 222 * MiB, WS_CKV = 258 * MiB, WS_KR = 282 * MiB, WS_D = 288 * MiB;
constexpr size_t WS_NAQKV = 54 * MiB, WS_H1 = 342 * MiB, WS_END = 438 * MiB;
constexpr int LDS_BYTES = 139264;

__device__ const double c_inv[32] = {1.0, 0.7498942093324559, 0.5623413251903491, 0.4216965034285822, 0.31622776601683794, 0.23713737056616552, 0.1778279410038923, 0.1333521432163324, 0.1, 0.07498942093324558, 0.05623413251903491, 0.042169650342858224, 0.03162277660168379, 0.023713737056616554, 0.01778279410038923, 0.01333521432163324, 0.01, 0.007498942093324558, 0.005623413251903491, 0.004216965034285823, 0.0031622776601683794, 0.0023713737056616554, 0.0017782794100389228, 0.001333521432163324, 0.001, 0.0007498942093324559, 0.0005623413251903491, 0.00042169650342858224, 0.00031622776601683794, 0.00023713737056616554, 0.00017782794100389227, 0.0001333521432163324};

struct Params {
  const float *xp, *xs, *attn_norm, *mlp_norm, *final_norm, *w_dq, *q_norm, *w_uq, *w_dkv, *kv_norm, *w_ukv, *w_o, *na_w_qkv, *na_rpb, *na_w_o, *w1, *w2;
  float* out; char* ws;
};

DI unsigned cvtpk(float lo, float hi) { unsigned r; asm volatile("v_cvt_pk_bf16_f32 %0, %1, %2" : "=v"(r) : "v"(lo), "v"(hi)); return r; }
DI float bflo(unsigned w) { return __uint_as_float(w << 16); }
DI float bfhi(unsigned w) { return __uint_as_float(w & 0xffff0000u); }
DI int crow(int r, int hi) { return (r & 3) + 8 * (r >> 2) + 4 * hi; }
DI int tok_pos(int g) { return g < TP ? (g & 16383) : ((g - TP) & 4095); }
DI float wave_sum(float v) {
#pragma unroll
  for (int o = 32; o > 0; o >>= 1) v += __shfl_xor(v, o, 64);
  return v;
}

DI void convert_matrix(int tid__, int bid__, const float* __restrict__ W, u16* __restrict__ Wt, int K, int N, char* lds) {
  float* tile = (float*)lds;
  const int tid = tid__;
  const int tn = N >> 6, nt = tn * (K >> 6);
  for (int t = bid__; t < nt; t += gridDim.x) {
    const int k0 = (t / tn) << 6, n0 = (t % tn) << 6;
    const int lr = tid >> 4, lc = (tid & 15) << 2;
#pragma unroll
    for (int i = 0; i < 2; ++i) {
      const f32x4 v = *(const f32x4*)(W + (long)(k0 + lr + 32 * i) * N + n0 + lc);
      float* d = tile + (lr + 32 * i) * 65 + lc;
      d[0] = v[0]; d[1] = v[1]; d[2] = v[2]; d[3] = v[3];
    }
    __syncthreads();
    const int n = tid >> 3, kc = (tid & 7) << 3;
    const float* s = tile + kc * 65 + n;
    u32x4 o;
    o[0] = cvtpk(s[0], s[65]); o[1] = cvtpk(s[130], s[195]); o[2] = cvtpk(s[260], s[325]); o[3] = cvtpk(s[390], s[455]);
    *(u32x4*)(Wt + (long)(n0 + n) * K + k0 + kc) = o;
    __syncthreads();
  }
}

DI void phase_prologue(int tid__, int bid__, const Params& p, char* lds) {
  char* ws = p.ws;
  convert_matrix(tid__, bid__, p.w_dq, (u16*)(ws + W_DQKV), 1024, 384, lds);
  convert_matrix(tid__, bid__, p.w_dkv, (u16*)(ws + W_DQKV) + 384 * 1024, 1024, 320, lds);
  convert_matrix(tid__, bid__, p.w_uq, (u16*)(ws + W_UQ), 384, 3072, lds);
  convert_matrix(tid__, bid__, p.w_ukv, (u16*)(ws + W_UKV), 256, 4096, lds);
  convert_matrix(tid__, bid__, p.w_o, (u16*)(ws + W_O), 2048, 1024, lds);
  convert_matrix(tid__, bid__, p.na_w_qkv, (u16*)(ws + W_NAQKV), 1024, 3072, lds);
  convert_matrix(tid__, bid__, p.na_w_o, (u16*)(ws + W_NAO), 1024, 1024, lds);
  convert_matrix(tid__, bid__, p.w1, (u16*)(ws + W_W1), 1024, 4096, lds);
  convert_matrix(tid__, bid__, p.w1 + 1024 * 4096, (u16*)(ws + W_W1) + 4096 * 1024, 1024, 4096, lds);
  convert_matrix(tid__, bid__, p.w2, (u16*)(ws + W_W2), 4096, 1024, lds);
  convert_matrix(tid__, bid__, p.w2 + 1024 * 4096, (u16*)(ws + W_W2) + 4096 * 1024, 4096, 1024, lds);
  const int gt = bid__ * NTHR + tid__, gs = gridDim.x * NTHR;
  for (int i = gt; i < 8192; i += gs) ((u32x4*)((u16*)(ws + W_DQKV) + 704 * 1024))[i] = (u32x4){0u, 0u, 0u, 0u};
  float2* rope = (float2*)(ws + WS_ROPE);
  for (int i = gt; i < 16384 * 32; i += gs) {
    const int pos = i >> 5, k = i & 31;
    const double rev = (double)pos * c_inv[k] * 0.15915494309189535;
    const float f = (float)(rev - floor(rev));
    rope[i] = make_float2(__builtin_amdgcn_cosf(f), __builtin_amdgcn_sinf(f));
  }
}

DI void phase_rmsnorm_bf16(int tid__, int bid__, const float* src0, const float* src1, int split, const float* __restrict__ g, u16* __restrict__ H) {
  const int wid = tid__ >> 6, lane = tid__ & 63;
  f32x4 gv[4];
#pragma unroll
  for (int i = 0; i < 4; ++i) gv[i] = *(const f32x4*)(g + lane * 4 + 256 * i);
  for (int row = bid__ * 8 + wid; row < TT; row += gridDim.x * 8) {
    const float* x = row < split ? src0 + (long)row * DM : src1 + (long)(row - split) * DM;
    f32x4 v[4]; float ss = 0.f;
#pragma unroll
    for (int i = 0; i < 4; ++i) { v[i] = *(const f32x4*)(x + lane * 4 + 256 * i); ss += v[i][0] * v[i][0] + v[i][1] * v[i][1] + v[i][2] * v[i][2] + v[i][3] * v[i][3]; }
    ss = wave_sum(ss);
    const float rs = rsqrtf(ss * (1.f / DM) + EPS);
#pragma unroll
    for (int i = 0; i < 4; ++i) {
      u32x2 o; o[0] = cvtpk(v[i][0] * rs * gv[i][0], v[i][1] * rs * gv[i][1]); o[1] = cvtpk(v[i][2] * rs * gv[i][2], v[i][3] * rs * gv[i][3]);
      *(u32x2*)(H + (long)row * DM + lane * 4 + 256 * i) = o;
    }
  }
}
DI void phase_rmsnorm_final(int tid__, int bid__, float* x, const float* __restrict__ g) {
  const int wid = tid__ >> 6, lane = tid__ & 63;
  f32x4 gv[4];
#pragma unroll
  for (int i = 0; i < 4; ++i) gv[i] = *(const f32x4*)(g + lane * 4 + 256 * i);
  for (int row = bid__ * 8 + wid; row < TT; row += gridDim.x * 8) {
    float* xr = x + (long)row * DM;
    f32x4 v[4]; float ss = 0.f;
#pragma unroll
    for (int i = 0; i < 4; ++i) { v[i] = *(const f32x4*)(xr + lane * 4 + 256 * i); ss += v[i][0] * v[i][0] + v[i][1] * v[i][1] + v[i][2] * v[i][2] + v[i][3] * v[i][3]; }
    ss = wave_sum(ss);
    const float rs = rsqrtf(ss * (1.f / DM) + EPS);
#pragma unroll
    for (int i = 0; i < 4; ++i) {
      f32x4 o; o[0] = v[i][0] * rs * gv[i][0]; o[1] = v[i][1] * rs * gv[i][1]; o[2] = v[i][2] * rs * gv[i][2]; o[3] = v[i][3] * rs * gv[i][3];
      *(f32x4*)(xr + lane * 4 + 256 * i) = o;
    }
  }
}
DI void phase_lat_norm(int tid__, int bid__, const u16* __restrict__ CQKV, const float* __restrict__ qn, const float* __restrict__ kvn, const float2* __restrict__ rope,
                               u16* __restrict__ CQ, u16* __restrict__ CKV, u16* __restrict__ KR) {
  const int wid = tid__ >> 6, lane = tid__ & 63;
  for (int row = bid__ * 8 + wid; row < TT; row += gridDim.x * 8) {
    const u16* x = CQKV + (long)row * 768;
    unsigned q[3], c[2]; float sq = 0.f, sc = 0.f;
#pragma unroll
    for (int i = 0; i < 3; ++i) { q[i] = *(const unsigned*)(x + lane * 2 + 128 * i); const float a = bflo(q[i]), b = bfhi(q[i]); sq += a * a + b * b; }
#pragma unroll
    for (int i = 0; i < 2; ++i) { c[i] = *(const unsigned*)(x + 384 + lane * 2 + 128 * i); const float a = bflo(c[i]), b = bfhi(c[i]); sc += a * a + b * b; }
    const float kr = __uint_as_float((unsigned)x[640 + lane] << 16);
    sq = wave_sum(sq); sc = wave_sum(sc);
    const float rq = rsqrtf(sq * (1.f / 384.f) + EPS), rc = rsqrtf(sc * (1.f / 256.f) + EPS);
#pragma unroll
    for (int i = 0; i < 3; ++i) { const int e = lane * 2 + 128 * i; *(unsigned*)(CQ + (long)row * 384 + e) = cvtpk(bflo(q[i]) * rq * qn[e], bfhi(q[i]) * rq * qn[e + 1]); }
#pragma unroll
    for (int i = 0; i < 2; ++i) { const int e = lane * 2 + 128 * i; *(unsigned*)(CKV + (long)row * 256 + e) = cvtpk(bflo(c[i]) * rc * kvn[e], bfhi(c[i]) * rc * kvn[e + 1]); }
    const float other = __shfl_xor(kr, 32, 64);
    const float2 cs = rope[tok_pos(row) * 32 + (lane & 31)];
    const float o = lane < 32 ? kr * cs.x - other * cs.y : other * cs.y + kr * cs.x;
    KR[(long)row * 64 + lane] = (u16)(cvtpk(o, 0.f) & 0xffffu);
  }
}

enum { EPI_BF16 = 0, EPI_QROPE = 1, EPI_RELU2 = 2, EPI_RESID = 3 };
struct EpiArgs { u16* C16; int ldc; float* Cf; const float* R; const float2* rope; int row0; };

template <int EPI>
DI void gemm_tile(int tid__, int bid__, const u16* __restrict__ A, int lda, const u16* __restrict__ Bt, int K, int m0, int n0, const EpiArgs& ea, char* lds) {
  const int tid = tid__, wid = tid >> 6, lane = tid & 63, r32 = lane & 31, hi = lane >> 5;
  const int wm = wid >> 2, wn = wid & 3;
  f32x16 acc[4][2];
#pragma unroll
  for (int i = 0; i < 4; ++i)
#pragma unroll
    for (int j = 0; j < 2; ++j)
#pragma unroll
      for (int r = 0; r < 16; ++r) acc[i][j][r] = 0.f;
  const int srow = tid >> 3, sch = tid & 7;
  const u16* Ag = A + (long)(m0 + srow) * lda + sch * 8;
  const u16* Bg = Bt + (long)(n0 + srow) * K + sch * 8;
  const int soff = srow * 128 + ((sch ^ ((srow >> 1) & 7)) << 4);
  const int xr = (r32 >> 1) & 7;
  const int aoff = (wm * 128 + r32) * 128, boff = 32768 + (wn * 64 + r32) * 128;
  bf16x8 sa[4], sb[4];
  const int nk = K >> 6;
#define G_LOAD(kt) do { _Pragma("unroll") for (int i = 0; i < 4; ++i) { sa[i] = *(const bf16x8*)(Ag + (long)(i * 64) * lda + (kt) * 64); sb[i] = *(const bf16x8*)(Bg + (long)(i * 64) * K + (kt) * 64); } } while (0)
#define G_WRITE(buf) do { char* b_ = lds + (buf) * 65536 + soff; _Pragma("unroll") for (int i = 0; i < 4; ++i) { *(bf16x8*)(b_ + i * 8192) = sa[i]; *(bf16x8*)(b_ + 32768 + i * 8192) = sb[i]; } } while (0)
  G_LOAD(0); G_WRITE(0); __syncthreads();
  for (int kt = 0; kt < nk; ++kt) {
    const int cur = kt & 1;
    if (kt + 1 < nk) G_LOAD(kt + 1);
    const char* base = lds + cur * 65536;
#pragma unroll
    for (int ks = 0; ks < 4; ++ks) {
      const int co = ((ks * 2 + hi) ^ xr) << 4;
      bf16x8 af[4], bfr[2];
#pragma unroll
      for (int mb = 0; mb < 4; ++mb) af[mb] = *(const bf16x8*)(base + aoff + mb * 4096 + co);
#pragma unroll
      for (int nb = 0; nb < 2; ++nb) bfr[nb] = *(const bf16x8*)(base + boff + nb * 4096 + co);
#pragma unroll
      for (int mb = 0; mb < 4; ++mb)
#pragma unroll
        for (int nb = 0; nb < 2; ++nb) acc[mb][nb] = MFMA32(af[mb], bfr[nb], acc[mb][nb]);
    }
    if (kt + 1 < nk) G_WRITE(cur ^ 1);
    __syncthreads();
  }
#undef G_LOAD
#undef G_WRITE
  const int rbase = m0 + wm * 128, cbase = n0 + wn * 64 + r32;
  if constexpr (EPI == EPI_QROPE) {
    if (((n0 + wn * 64) % 192) >= 128) {
#pragma unroll
      for (int mb = 0; mb < 4; ++mb)
#pragma unroll
        for (int r = 0; r < 16; ++r) {
          const int row = rbase + mb * 32 + crow(r, hi);
          const float2 cs = ea.rope[tok_pos(ea.row0 + row) * 32 + r32];
          const float x1 = acc[mb][0][r], x2 = acc[mb][1][r];
          acc[mb][0][r] = x1 * cs.x - x2 * cs.y; acc[mb][1][r] = x1 * cs.y + x2 * cs.x;
        }
    }
  }
#pragma unroll
  for (int mb = 0; mb < 4; ++mb)
#pragma unroll
    for (int nb = 0; nb < 2; ++nb)
#pragma unroll
      for (int r = 0; r < 16; ++r) {
        const int row = rbase + mb * 32 + crow(r, hi), col = cbase + nb * 32;
        float v = acc[mb][nb][r];
        if constexpr (EPI == EPI_RESID) {
          const long o = (long)row * ea.ldc + col;
          ea.Cf[o] = ea.R[o] + v;
        } else {
          if constexpr (EPI == EPI_RELU2) { v = fmaxf(v, 0.f); v = v * v; }
          ea.C16[(long)row * ea.ldc + col] = (u16)(cvtpk(v, 0.f) & 0xffffu);
        }
      }
}
template <int EPI>
DI void gemm_phase(int tid__, int bid__, const u16* A, int lda, const u16* Bt, int K, int M, int N, const EpiArgs& ea, char* lds) {
  const int nN = N >> 8, nt = (M >> 8) * nN;
  for (int t = bid__; t < nt; t += gridDim.x) gemm_tile<EPI>(tid__, bid__, A, lda, Bt, K, (t / nN) << 8, (t % nN) << 8, ea, lds);
}

constexpr float ATT_SCALE = 0.07216878364870323f;
constexpr float ATT_THR = 8.f;
constexpr int SHM_V = 16384, SHM_K = 24576;
constexpr int LDQ = 3072, LDKV = 4096, LDO = 2048;

DI void partialSM(f32x16& p0, f32x16& p1, float& m_reg, float& mn, float& alpha) {
  constexpr float C = ATT_SCALE * 1.4426950408889634f;
  float pmax = p0[0];
#pragma unroll
  for (int r = 1; r < 16; ++r) pmax = fmaxf(pmax, p0[r]);
#pragma unroll
  for (int r = 0; r < 16; ++r) pmax = fmaxf(pmax, p1[r]);
  { auto rr = __builtin_amdgcn_permlane32_swap(__float_as_uint(pmax), __float_as_uint(pmax), false, false);
    pmax = fmaxf(__uint_as_float(rr[0]), __uint_as_float(rr[1])); }
  if (__builtin_expect(__all(pmax - m_reg <= ATT_THR / ATT_SCALE), 1)) { mn = m_reg; alpha = 1.f; }
  else { mn = fmaxf(m_reg, pmax); alpha = __builtin_amdgcn_exp2f((m_reg - mn) * C); m_reg = mn; }
  const float mnC = -mn * C;
#pragma unroll
  for (int r = 0; r < 16; ++r) p0[r] = fmaf(p0[r], C, mnC);
#pragma unroll
  for (int r = 0; r < 16; ++r) p1[r] = fmaf(p1[r], C, mnC);
#pragma unroll
  for (int r = 0; r < 16; ++r) p0[r] = __builtin_amdgcn_exp2f(p0[r]);
}
DI void finishSM(f32x16& p0, f32x16& p1, float alpha, float& l_reg, bf16x8& pa0, bf16x8& pa1, bf16x8& pa2, bf16x8& pa3) {
#pragma unroll
  for (int r = 0; r < 16; ++r) p1[r] = __builtin_amdgcn_exp2f(p1[r]);
  float ps = 0;
#pragma unroll
  for (int r = 0; r < 16; ++r) ps += p0[r];
#pragma unroll
  for (int r = 0; r < 16; ++r) ps += p1[r];
  { auto rr = __builtin_amdgcn_permlane32_swap(__float_as_uint(ps), __float_as_uint(ps), false, false);
    ps = __uint_as_float(rr[0]) + __uint_as_float(rr[1]); }
  l_reg = l_reg * alpha + ps;
#define PK4(P, BASE, OUT) do { unsigned a0 = cvtpk(P[BASE + 0], P[BASE + 1]), a1 = cvtpk(P[BASE + 2], P[BASE + 3]);   \
    unsigned b0 = cvtpk(P[BASE + 4], P[BASE + 5]), b1 = cvtpk(P[BASE + 6], P[BASE + 7]);                              \
    auto r0 = __builtin_amdgcn_permlane32_swap(a0, b0, false, false); auto r1 = __builtin_amdgcn_permlane32_swap(a1, b1, false, false); \
    u32x4 w = {r0[0], r1[0], r0[1], r1[1]}; OUT = __builtin_bit_cast(bf16x8, w); } while (0)
  PK4(p0, 0, pa0); PK4(p0, 8, pa1); PK4(p1, 0, pa2); PK4(p1, 8, pa3);
#undef PK4
}
DI void qkt(f32x16& p0, f32x16& p1, const char* Ks, const bf16x8* qr, const char* Qs, int k0, int k1, int k2, int k3) {
#pragma unroll
  for (int r = 0; r < 16; ++r) { p0[r] = 0.f; p1[r] = 0.f; }
#pragma unroll
  for (int d0 = 0; d0 < 12; ++d0) {
    const int off = ((d0 & 3) == 0 ? k0 : (d0 & 3) == 1 ? k1 : (d0 & 3) == 2 ? k2 : k3) + (d0 >> 2) * 128;
    const bf16x8 b0 = *(const bf16x8*)(Ks + off);
    const bf16x8 b1 = *(const bf16x8*)(Ks + off + 32 * 384);
    const bf16x8 qv = d0 < 8 ? qr[d0 & 7] : *(const bf16x8*)(Qs + (d0 - 8) * 1024);
    p0 = MFMA32(b0, qv, p0);
    p1 = MFMA32(b1, qv, p1);
  }
}
DI int v_st(int k, int c) { const int kk = (k & ~0xC) | ((k & 4) << 1) | ((k & 8) >> 1); return ((kk >> 3) * 4 + (c >> 5)) * 512 + ((kk & 7) * 32 + (c & 31)) * 2; }
DI int v_rd_base(int lane) { return ((lane & 3) << 3) | (((lane >> 2) & 3) << 6) | (((lane >> 4) & 1) << 5) | (((lane >> 5) & 1) << 8); }
constexpr int v_rd_off(int d0, int ks, int half) { return d0 * 512 + ks * 4096 + half * 2048; }
template <int OFF> DI s16x4 tr_read(int vb) {
  s16x4 r; asm volatile("ds_read_b64_tr_b16 %0, %1 offset:%2" : "=&v"(r) : "v"(vb), "i"(OFF) : "memory"); return r;
}
template <int D0> DI void pv_one(f32x16& od, int vb, bf16x8 pa0, bf16x8 pa1, bf16x8 pa2, bf16x8 pa3) {
  const s16x4 l0 = tr_read<v_rd_off(D0, 0, 0)>(vb), h0 = tr_read<v_rd_off(D0, 0, 1)>(vb), l1 = tr_read<v_rd_off(D0, 1, 0)>(vb), h1 = tr_read<v_rd_off(D0, 1, 1)>(vb);
  const s16x4 l2 = tr_read<v_rd_off(D0, 2, 0)>(vb), h2 = tr_read<v_rd_off(D0, 2, 1)>(vb), l3 = tr_read<v_rd_off(D0, 3, 0)>(vb), h3 = tr_read<v_rd_off(D0, 3, 1)>(vb);
  asm volatile("s_waitcnt lgkmcnt(0)" ::: "memory"); SBAR();
#define PK(L, H) (bf16x8){L[0], L[1], L[2], L[3], H[0], H[1], H[2], H[3]}
  od = MFMA32(pa0, PK(l0, h0), od);
  od = MFMA32(pa1, PK(l1, h1), od);
  od = MFMA32(pa2, PK(l2, h2), od);
  od = MFMA32(pa3, PK(l3, h3), od);
#undef PK
}
DI void pv_d0(f32x16* o, int vb, bf16x8 pa0, bf16x8 pa1, bf16x8 pa2, bf16x8 pa3) {
  pv_one<0>(o[0], vb, pa0, pa1, pa2, pa3); pv_one<1>(o[1], vb, pa0, pa1, pa2, pa3); pv_one<2>(o[2], vb, pa0, pa1, pa2, pa3); pv_one<3>(o[3], vb, pa0, pa1, pa2, pa3);
}

DI void attn_tile(int tid__, int bid__, const u16* __restrict__ Qb, const u16* __restrict__ Kh, const u16* __restrict__ Vh, const u16* __restrict__ KRb, u16* __restrict__ Ob, int seq, char* lds) {
  const int tid = tid__, wid = tid >> 6, lane = tid & 63, r32 = lane & 31, hi = lane >> 5;
  char* V_lds = lds; char* K_lds = lds + 2 * SHM_V;
  float* wsf = (float*)(lds + 2 * SHM_V + 2 * SHM_K) + wid * 64; float* li_l = wsf; float* al_l = wsf + 32;
  float m_reg = -1e30f, l_reg = 0; f32x16 o[4]; bf16x8 qr[8];
#pragma unroll
  for (int d = 0; d < 4; ++d)
#pragma unroll
    for (int r = 0; r < 16; ++r) o[d][r] = 0.f;
  const u16* Qw = Qb + (long)(wid * 32 + r32) * LDQ + hi * 8;
#pragma unroll
  for (int d0 = 0; d0 < 8; ++d0) qr[d0] = *(const bf16x8*)(Qw + d0 * 16);
  char* Qs = lds + 2 * SHM_V + 2 * SHM_K + 2048 + wid * 4096 + lane * 16;
  const int sr = tid >> 4, sc = (tid & 15) * 8, vst0 = v_st(sr, sc), vst1 = v_st(32 + sr, sc);
  const int kst0 = sr * 384 + ((sc * 2) ^ (((sr >> 1) & 7) << 4)), kst1 = kst0 + 32 * 384;
  const int rr = tid >> 3, rc = (tid & 7) * 8;
  const int kst2 = rr * 384 + 256 + ((rc * 2) ^ (((rr >> 1) & 7) << 4));
  const int vb0 = (int)(uintptr_t)V_lds + v_rd_base(lane);
  const int xs = ((r32 >> 1) & 7) << 4, kb = r32 * 384;
  const int k0 = kb + ((hi * 16) ^ xs), k1 = kb + ((32 + hi * 16) ^ xs), k2 = kb + ((64 + hi * 16) ^ xs), k3 = kb + ((96 + hi * 16) ^ xs);
  bf16x8 vs0, vs1, ks0, ks1, ks2;
#define SLOAD(kk) do { vs0 = *(const bf16x8*)(Vh + (long)((kk) + sr) * LDKV + sc); vs1 = *(const bf16x8*)(Vh + (long)((kk) + 32 + sr) * LDKV + sc); \
    ks0 = *(const bf16x8*)(Kh + (long)((kk) + sr) * LDKV + sc); ks1 = *(const bf16x8*)(Kh + (long)((kk) + 32 + sr) * LDKV + sc); \
    ks2 = *(const bf16x8*)(KRb + (long)((kk) + rr) * 64 + rc); } while (0)
#define SWRITE(b) do { *(bf16x8*)(V_lds + (b) * SHM_V + vst0) = vs0; *(bf16x8*)(V_lds + (b) * SHM_V + vst1) = vs1; \
    *(bf16x8*)(K_lds + (b) * SHM_K + kst0) = ks0; *(bf16x8*)(K_lds + (b) * SHM_K + kst1) = ks1; *(bf16x8*)(K_lds + (b) * SHM_K + kst2) = ks2; } while (0)
#define SWAIT() asm volatile("s_waitcnt vmcnt(0)" ::: "memory")
#define RESC(a) do { if (__any((a) < 1.f)) { if (hi == 0) al_l[r32] = (a); asm volatile("s_waitcnt lgkmcnt(0)" ::: "memory"); \
    _Pragma("unroll") for (int d = 0; d < 4; ++d) _Pragma("unroll") for (int r = 0; r < 16; ++r) o[d][r] *= al_l[crow(r, hi)]; } } while (0)
  f32x16 pA0, pA1, pB0, pB1; float mnA, mnB, alA, alB; bf16x8 pa0, pa1, pa2, pa3; const int NT = seq / 64;
  __syncthreads();
  {
    bf16x8 qx[4];
#pragma unroll
    for (int i = 0; i < 4; ++i) qx[i] = *(const bf16x8*)(Qw + 128 + i * 16);
#pragma unroll
    for (int i = 0; i < 4; ++i) *(bf16x8*)(Qs + i * 1024) = qx[i];
  }
  SLOAD(0); SWAIT(); SWRITE(0); __syncthreads();
  qkt(pA0, pA1, K_lds, qr, Qs, k0, k1, k2, k3); partialSM(pA0, pA1, m_reg, mnA, alA);
  SLOAD(64);
  SWAIT(); SWRITE(1); __syncthreads();
  for (int j = 1; j + 1 < NT; j += 2) {
    SBAR(); qkt(pB0, pB1, K_lds + SHM_K, qr, Qs, k0, k1, k2, k3);
    finishSM(pA0, pA1, alA, l_reg, pa0, pa1, pa2, pa3); SBAR();
    SLOAD((j + 1) * 64); SBAR();
    pv_d0(o, vb0, pa0, pa1, pa2, pa3); partialSM(pB0, pB1, m_reg, mnB, alB);
    __syncthreads(); SWAIT(); SWRITE(0);
    RESC(alB); __syncthreads();
    SBAR(); qkt(pA0, pA1, K_lds, qr, Qs, k0, k1, k2, k3);
    finishSM(pB0, pB1, alB, l_reg, pa0, pa1, pa2, pa3); SBAR();
    SLOAD((j + 2) * 64); SBAR();
    pv_d0(o, vb0 + SHM_V, pa0, pa1, pa2, pa3); partialSM(pA0, pA1, m_reg, mnA, alA);
    __syncthreads(); SWAIT(); SWRITE(1);
    RESC(alA); __syncthreads();
  }
  SBAR(); qkt(pB0, pB1, K_lds + SHM_K, qr, Qs, k0, k1, k2, k3);
  finishSM(pA0, pA1, alA, l_reg, pa0, pa1, pa2, pa3); SBAR();
  pv_d0(o, vb0, pa0, pa1, pa2, pa3); partialSM(pB0, pB1, m_reg, mnB, alB);
  __syncthreads(); RESC(alB);
  finishSM(pB0, pB1, alB, l_reg, pa0, pa1, pa2, pa3); SBAR();
  pv_d0(o, vb0 + SHM_V, pa0, pa1, pa2, pa3);
  if (hi == 0) li_l[r32] = l_reg; asm volatile("s_waitcnt lgkmcnt(0)" ::: "memory");
  float rli[16];
#pragma unroll
  for (int r = 0; r < 16; ++r) rli[r] = __builtin_amdgcn_rcpf(li_l[crow(r, hi)]);
  u16* Ow = Ob + (long)(wid * 32) * LDO;
#pragma unroll
  for (int r = 0; r < 16; ++r) { const int orow = crow(r, hi);
#pragma unroll
    for (int d0 = 0; d0 < 4; ++d0) Ow[(long)orow * LDO + d0 * 32 + r32] = (u16)(cvtpk(o[d0][r] * rli[r], 0.f) & 0xffffu); }
#undef SLOAD
#undef SWRITE
#undef SWAIT
#undef RESC
}

DI void phase_attn(int tid__, int bid__, const u16* Q, const u16* KV, const u16* KRc, u16* O, int c, char* lds) {
  for (int v = bid__; v < 1024; v += gridDim.x) {
    const int x = v & 7, slot = (v >> 3) & 31, rnd = v >> 8;
    int h, tok0, key0, seq;
    if (c < 2) { h = x + 8 * (rnd >> 1); const int qb = slot + 32 * (rnd & 1); tok0 = qb * 256; key0 = 0; seq = 16384; }
    else { const int pr = x + 8 * (2 * rnd + (slot >> 4)); const int b = pr >> 4; h = pr & 15; key0 = b * 4096; tok0 = key0 + (slot & 15) * 256; seq = 4096; }
    attn_tile(tid__, bid__, Q + (long)tok0 * LDQ + h * 192, KV + (long)key0 * LDKV + h * 256, KV + (long)key0 * LDKV + h * 256 + 128, KRc + (long)key0 * 64,
              O + (long)tok0 * LDO + h * 128, seq, lds);
  }
}

DI void phase_na(int tid__, int bid__, const u16* __restrict__ QKV, const float* __restrict__ rpb, u16* __restrict__ O, char* lds) {
  const int tid = tid__, c = tid & 63, w = tid >> 6;
  char* Kw = lds;
  float* P = (float*)(lds + 65536);
  float* mred = (float*)(lds + 65536 + 33024); float* sred = mred + 512; float* rp = sred + 512;
  const int cs = min(max(c - 8, 0), 48);
  for (int v = bid__; v < 12288; v += gridDim.x) {
    const int x = v & 7, u = v >> 3, h = u / 96, g = x * 96 + (u % 96);
    int rows, r, seqbase;
    if (g < 512) { rows = 256; r = g & 255; seqbase = (g >> 8) * 16384; } else { rows = 64; r = (g - 512) & 63; seqbase = TP + ((g - 512) >> 6) * 4096; }
    const int r0 = min(max(r - 4, 0), rows - 8);
    const u16* kbase = QKV + (long)(seqbase + r0 * 64) * 3072 + 1024 + h * 64;
    __syncthreads();
#pragma unroll
    for (int it = 0; it < 8; ++it) {
      const int key = (tid >> 3) + 64 * it, ch = tid & 7;
      *(bf16x8*)(Kw + key * 128 + ((ch ^ ((key >> 1) & 7)) << 4)) = *(const bf16x8*)(kbase + (long)key * 3072 + ch * 8);
    }
    if (tid < 465) rp[tid] = rpb[h * 465 + tid];
    float q[64];
    {
      const u16* qs = QKV + (long)(seqbase + r * 64 + c) * 3072 + h * 64;
#pragma unroll
      for (int i = 0; i < 8; ++i) { const u32x4 t = *(const u32x4*)(qs + i * 8);
#pragma unroll
        for (int j = 0; j < 4; ++j) { q[i * 8 + 2 * j] = bflo(t[j]); q[i * 8 + 2 * j + 1] = bfhi(t[j]); } }
    }
    __syncthreads();
    float mx = -1e30f;
    const int relrow = r0 + w - r + 7;
#pragma unroll 2
    for (int j = 0; j < 16; ++j) {
      const int key = w * 64 + cs + j;
      const int sw = (key >> 1) & 7;
      float d = 0.f;
#pragma unroll
      for (int ch = 0; ch < 8; ++ch) {
        const u32x4 t = *(const u32x4*)(Kw + key * 128 + ((ch ^ sw) << 4));
#pragma unroll
        for (int e = 0; e < 4; ++e) { d = fmaf(q[ch * 8 + 2 * e], bflo(t[e]), d); d = fmaf(q[ch * 8 + 2 * e + 1], bfhi(t[e]), d); }
      }
      const float s = d * 0.125f + rp[relrow * 31 + (cs + j - c + 15)];
      P[c * 129 + w * 16 + j] = s;
      mx = fmaxf(mx, s);
    }
    mred[w * 64 + c] = mx;
    __syncthreads();
    {
      bf16x8 vv[8];
#pragma unroll
      for (int it = 0; it < 8; ++it) vv[it] = *(const bf16x8*)(kbase + 1024 + (long)((tid >> 3) + 64 * it) * 3072 + (tid & 7) * 8);
      float M = mred[c];
#pragma unroll
      for (int i = 1; i < 8; ++i) M = fmaxf(M, mred[i * 64 + c]);
      float sum = 0.f;
#pragma unroll
      for (int j = 0; j < 16; ++j) { const float e = __expf(P[c * 129 + w * 16 + j] - M); sum += e; P[c * 129 + w * 16 + j] = e; }
      sred[w * 64 + c] = sum;
#pragma unroll
      for (int it = 0; it < 8; ++it) { const int key = (tid >> 3) + 64 * it, ch = tid & 7; *(bf16x8*)(Kw + key * 128 + ((ch ^ ((key >> 1) & 7)) << 4)) = vv[it]; }
    }
    __syncthreads();
    float L = 0.f;
#pragma unroll
    for (int i = 0; i < 8; ++i) L += sred[i * 64 + c];
    float acc[8];
#pragma unroll
    for (int e = 0; e < 8; ++e) acc[e] = 0.f;
    for (int i = 0; i < 8; ++i) {
#pragma unroll 4
      for (int j = 0; j < 16; ++j) {
        const int key = i * 64 + cs + j;
        const float pw = P[c * 129 + i * 16 + j];
        const u32x4 t = *(const u32x4*)(Kw + key * 128 + ((w ^ ((key >> 1) & 7)) << 4));
#pragma unroll
        for (int e = 0; e < 4; ++e) { acc[2 * e] = fmaf(pw, bflo(t[e]), acc[2 * e]); acc[2 * e + 1] = fmaf(pw, bfhi(t[e]), acc[2 * e + 1]); }
      }
    }
    const float il = 1.f / L;
    u32x4 ov;
#pragma unroll
    for (int e = 0; e < 4; ++e) ov[e] = cvtpk(acc[2 * e] * il, acc[2 * e + 1] * il);
    *(u32x4*)(O + (long)(seqbase + r * 64 + c) * 1024 + h * 64 + w * 8) = ov;
  }
}

enum { K_PRO = 0, K_RMS, K_LAT, K_G_BF16, K_G_QROPE, K_G_RELU2, K_G_RESID, K_ATTN, K_NA, K_FINAL };
constexpr int NSTEPS = 34;
__global__ void __launch_bounds__(NTHR) fwd_megakernel(Params p) {
  __shared__ __attribute__((aligned(16))) char lds[LDS_BYTES];
  cg::grid_group grid = cg::this_grid();
#pragma unroll 1
  for (int ph = 0; ph < NSTEPS; ++ph) {
    int tid__ = __builtin_amdgcn_workitem_id_x(), bid__ = __builtin_amdgcn_workgroup_id_x();
    asm volatile("" : "+v"(tid__), "+s"(bid__));
    char* ws = p.ws;
    int kind = K_FINAL, sync = 1, chunk = 0;
    const u16* gA = nullptr; const u16* gB = nullptr; int lda = 0, gK = 0, gM = 0, gN = 0;
    EpiArgs ea{nullptr, 0, nullptr, nullptr, nullptr, 0};
    const float* nsrc0 = p.out; const float* nsrc1 = p.out; int nsplit = TT; const float* ng = p.attn_norm; u16* nH = (u16*)(ws + WS_A);
    if (ph == 0) { kind = K_PRO; }
    else if (ph == 1) { kind = K_G_BF16; gA = (const u16*)(ws + WS_A); lda = DM; gB = (const u16*)(ws + W_DQKV); gK = 1024; gM = TT; gN = 768; ea.C16 = (u16*)(ws + WS_B); ea.ldc = 768; }
    else if (ph == 2) { kind = K_LAT; }
    else if (ph < 15) {
      const int c = (ph - 3) >> 2, sub = (ph - 3) & 3; chunk = c;
      if (sub == 0) { kind = K_G_QROPE; sync = 0; gA = (const u16*)(ws + WS_CQ) + (long)c * CH * 384; lda = 384; gB = (const u16*)(ws + W_UQ); gK = 384; gM = CH; gN = 3072;
                      ea.C16 = (u16*)(ws + WS_A); ea.ldc = 3072; ea.rope = (const float2*)(ws + WS_ROPE); ea.row0 = c * CH; }
      else if (sub == 1) { kind = K_G_BF16; gA = (const u16*)(ws + WS_CKV) + (long)c * CH * 256; lda = 256; gB = (const u16*)(ws + W_UKV); gK = 256; gM = CH; gN = 4096;
                           ea.C16 = (u16*)(ws + WS_D); ea.ldc = 4096; }
      else if (sub == 2) { kind = K_ATTN; }
      else { kind = K_G_RESID; gA = (const u16*)(ws + WS_B); lda = 2048; gB = (const u16*)(ws + W_O); gK = 2048; gM = CH; gN = DM;
             ea.ldc = DM; ea.Cf = p.out + (long)c * CH * DM; ea.R = c < 2 ? p.xp + (long)c * CH * DM : p.xs; }
    }
    else if (ph == 15 || ph == 26) { kind = K_RMS; ng = p.mlp_norm + (ph == 26 ? DM : 0); }
    else if (ph == 22) { kind = K_RMS; ng = p.attn_norm + DM; nH = (u16*)(ws + WS_H1); }
    else if (ph == 23) { kind = K_G_BF16; gA = (const u16*)(ws + WS_H1); lda = DM; gB = (const u16*)(ws + W_NAQKV); gK = 1024; gM = TT; gN = 3072; ea.C16 = (u16*)(ws + WS_NAQKV); ea.ldc = 3072; }
    else if (ph == 24) { kind = K_NA; }
    else if (ph == 25) { kind = K_G_RESID; gA = (const u16*)(ws + WS_H1); lda = DM; gB = (const u16*)(ws + W_NAO); gK = 1024; gM = TT; gN = DM; ea.ldc = DM; ea.Cf = p.out; ea.R = p.out; }
    else if (ph < 33) {
      const int layer = ph >= 27 ? 1 : 0, q = ph - (layer ? 27 : 16), c = q >> 1;
      if ((q & 1) == 0) { kind = K_G_RELU2; gA = (const u16*)(ws + WS_A) + (long)c * CH * DM; lda = DM; gB = (const u16*)(ws + W_W1) + (long)layer * 4096 * 1024; gK = 1024; gM = CH; gN = 4096;
                          ea.C16 = (u16*)(ws + WS_D); ea.ldc = 4096; }
      else { kind = K_G_RESID; gA = (const u16*)(ws + WS_D); lda = 4096; gB = (const u16*)(ws + W_W2) + (long)layer * 4096 * 1024; gK = 4096; gM = CH; gN = DM;
             ea.ldc = DM; ea.Cf = p.out + (long)c * CH * DM; ea.R = ea.Cf; }
    }
    else { kind = K_FINAL; sync = 0; }

    switch (kind) {
      case K_PRO:
        phase_prologue(tid__, bid__, p, lds);
        phase_rmsnorm_bf16(tid__, bid__, p.xp, p.xs, TP, p.attn_norm, (u16*)(ws + WS_A));
        break;
      case K_RMS: phase_rmsnorm_bf16(tid__, bid__, nsrc0, nsrc1, nsplit, ng, nH); break;
      case K_LAT: phase_lat_norm(tid__, bid__, (const u16*)(ws + WS_B), p.q_norm, p.kv_norm, (const float2*)(ws + WS_ROPE), (u16*)(ws + WS_CQ), (u16*)(ws + WS_CKV), (u16*)(ws + WS_KR)); break;
      case K_G_BF16: gemm_phase<EPI_BF16>(tid__, bid__, gA, lda, gB, gK, gM, gN, ea, lds); break;
      case K_G_QROPE: gemm_phase<EPI_QROPE>(tid__, bid__, gA, lda, gB, gK, gM, gN, ea, lds); break;
      case K_G_RELU2: gemm_phase<EPI_RELU2>(tid__, bid__, gA, lda, gB, gK, gM, gN, ea, lds); break;
      case K_G_RESID: gemm_phase<EPI_RESID>(tid__, bid__, gA, lda, gB, gK, gM, gN, ea, lds); break;
      case K_ATTN: phase_attn(tid__, bid__, (const u16*)(ws + WS_A), (const u16*)(ws + WS_D), (const u16*)(ws + WS_KR) + (long)chunk * CH * 64, (u16*)(ws + WS_B), chunk, lds); break;
      case K_NA: phase_na(tid__, bid__, (const u16*)(ws + WS_NAQKV), p.na_rpb, (u16*)(ws + WS_H1), lds); break;
      default: phase_rmsnorm_final(tid__, bid__, p.out, p.final_norm); break;
    }
    if (sync) grid.sync();
  }
}

extern "C" void kernel_launch(void* const* d_in, const int* in_sizes, int n_in, void* d_out, int out_size, void* d_ws, size_t ws_size, hipStream_t stream) {
  static int grid_blocks = 0;
  if (!grid_blocks) {
    int dev = 0, cus = 0, per_cu = 0;
    hipGetDevice(&dev);
    hipDeviceGetAttribute(&cus, hipDeviceAttributeMultiprocessorCount, dev);
    hipOccupancyMaxActiveBlocksPerMultiprocessor(&per_cu, fwd_megakernel, NTHR, 0);
    if (per_cu < 1) per_cu = 1;
    grid_blocks = cus * per_cu;
    if (ws_size < WS_END) fprintf(stderr, "kernel_launch: workspace too small: %zu < %zu\n", ws_size, (size_t)WS_END);
  }
  Params p{};
  p.xp = (const float*)d_in[0]; p.xs = (const float*)d_in[1]; p.attn_norm = (const float*)d_in[2]; p.mlp_norm = (const float*)d_in[3];
  p.final_norm = (const float*)d_in[4]; p.w_dq = (const float*)d_in[5]; p.q_norm = (const float*)d_in[6]; p.w_uq = (const float*)d_in[7];
  p.w_dkv = (const float*)d_in[8]; p.kv_norm = (const float*)d_in[9]; p.w_ukv = (const float*)d_in[10]; p.w_o = (const float*)d_in[11];
  p.na_w_qkv = (const float*)d_in[12]; p.na_rpb = (const float*)d_in[13]; p.na_w_o = (const float*)d_in[14]; p.w1 = (const float*)d_in[15];
  p.w2 = (const float*)d_in[16]; p.out = (float*)d_out; p.ws = (char*)d_ws;
  void* args[] = {&p};
  hipError_t e = hipLaunchCooperativeKernel((void*)fwd_megakernel, dim3(grid_blocks), dim3(NTHR), args, 0, stream);
  if (e != hipSuccess) fprintf(stderr, "cooperative launch failed: %s (grid %d)\n", hipGetErrorString(e), grid_blocks);
}
```

```cpp
#include <hip/hip_runtime.h>
#include <hip/hip_cooperative_groups.h>
#include <cstdio>
#include <cstdint>
namespace cg = cooperative_groups;

typedef unsigned short u16;
using bf16x8 = __attribute__((ext_vector_type(8))) short;
using s16x4  = __attribute__((ext_vector_type(4))) short;
using f32x16 = __attribute__((ext_vector_type(16))) float;
using f32x4  = __attribute__((ext_vector_type(4))) float;
using u32x4  = __attribute__((ext_vector_type(4))) unsigned;
using u32x2  = __attribute__((ext_vector_type(2))) unsigned;
#define DI __device__ __forceinline__
#define SBAR() __builtin_amdgcn_sched_barrier(0)
#define MFMA32(a, b, c) __builtin_amdgcn_mfma_f32_32x32x16_bf16((a), (b), (c), 0, 0, 0)

constexpr int DM = 1024, TP = 32768, TS = 16384, TT = 49152, CH = 16384;
constexpr int NTHR = 512;
constexpr float EPS = 1e-6f;
constexpr size_t MiB = 1048576;
constexpr size_t W_DQKV = 0, W_UQ = 1572864, W_UKV = 3932160, W_O = 6029312, W_NAQKV = 10223616, W_NAO = 16515072, W_W1 = 18612224, W_W2 = 35389440;
constexpr size_t WS_ROPE = 50 * MiB, WS_A = 54 * MiB, WS_B = 150 * MiB, WS_CQ = 222 * MiB, WS_CKV = 258 * MiB, WS_KR = 282 * MiB, WS_D = 288 * MiB;
constexpr size_t WS_NAQKV = 54 * MiB, WS_H1 = 342 * MiB, WS_BAR = 52166656, WS_SS = 52166656 + 16384, WS_END = 438 * MiB;
constexpr int LDS_BYTES = 147456;

__device__ const double c_inv[32] = {1.0, 0.7498942093324559, 0.5623413251903491, 0.4216965034285822, 0.31622776601683794, 0.23713737056616552, 0.1778279410038923, 0.1333521432163324, 0.1, 0.07498942093324558, 0.05623413251903491, 0.042169650342858224, 0.03162277660168379, 0.023713737056616554, 0.01778279410038923, 0.01333521432163324, 0.01, 0.007498942093324558, 0.005623413251903491, 0.004216965034285823, 0.0031622776601683794, 0.0023713737056616554, 0.0017782794100389228, 0.001333521432163324, 0.001, 0.0007498942093324559, 0.0005623413251903491, 0.00042169650342858224, 0.00031622776601683794, 0.00023713737056616554, 0.00017782794100389227, 0.0001333521432163324};

struct Params {
  const float *xp, *xs, *attn_norm, *mlp_norm, *final_norm, *w_dq, *q_norm, *w_uq, *w_dkv, *kv_norm, *w_ukv, *w_o, *na_w_qkv, *na_rpb, *na_w_o, *w1, *w2;
  float* out; char* ws;
};

DI unsigned cvtpk(float lo, float hi) { unsigned r; asm volatile("v_cvt_pk_bf16_f32 %0, %1, %2" : "=v"(r) : "v"(lo), "v"(hi)); return r; }
DI float bflo(unsigned w) { return __uint_as_float(w << 16); }
DI float bfhi(unsigned w) { return __uint_as_float(w & 0xffff0000u); }
DI int crow(int r, int hi) { return (r & 3) + 8 * (r >> 2) + 4 * hi; }
DI int tok_pos(int g) { return g < TP ? (g & 16383) : ((g - TP) & 4095); }
#define SWZ_XOR(v, k) __int_as_float(__builtin_amdgcn_ds_swizzle(__float_as_int(v), ((k) << 10) | 0x1f))
DI float wave_sum(float v) {
  v += SWZ_XOR(v, 1); v += SWZ_XOR(v, 2); v += SWZ_XOR(v, 4); v += SWZ_XOR(v, 8); v += SWZ_XOR(v, 16);
  auto rr = __builtin_amdgcn_permlane32_swap(__float_as_uint(v), __float_as_uint(v), false, false);
  return __uint_as_float(rr[0]) + __uint_as_float(rr[1]);
}

template <bool QPERM = false>
DI void convert_matrix(int tid__, int bid__, const float* __restrict__ W, u16* __restrict__ Wt, int K, int N, char* lds, const float* __restrict__ gain = nullptr) {
  float* tile = (float*)lds;
  const int tid = tid__;
  const int tn = N >> 6, nt = tn * (K >> 6);
  for (int t = bid__; t < nt; t += gridDim.x) {
    const int k0 = (t / tn) << 6, n0 = (t % tn) << 6;
    const int lr = tid >> 4, lc = (tid & 15) << 2;
#pragma unroll
    for (int i = 0; i < 2; ++i) {
      f32x4 v = *(const f32x4*)(W + (long)(k0 + lr + 32 * i) * N + n0 + lc);
      if (gain) { const float gk = gain[k0 + lr + 32 * i]; v[0] *= gk; v[1] *= gk; v[2] *= gk; v[3] *= gk; }
      float* d = tile + (lr + 32 * i) * 65 + lc;
      d[0] = v[0]; d[1] = v[1]; d[2] = v[2]; d[3] = v[3];
    }
    __syncthreads();
    const int n = tid >> 3, kc = (tid & 7) << 3;
    const float* s = tile + kc * 65 + n;
    u32x4 o;
    o[0] = cvtpk(s[0], s[65]); o[1] = cvtpk(s[130], s[195]); o[2] = cvtpk(s[260], s[325]); o[3] = cvtpk(s[390], s[455]);
    int nd = n0 + n;
    if (QPERM) { const int hc = nd % 192; if (hc >= 128) { const int e = hc - 128; nd = nd - hc + 128 + 2 * (e & 31) + (e >> 5); } }
    *(u32x4*)(Wt + (long)nd * K + k0 + kc) = o;
    __syncthreads();
  }
}

DI void phase_prologue(int tid__, int bid__, const Params& p, char* lds) {
  char* ws = p.ws;
  convert_matrix(tid__, bid__, p.w_dq, (u16*)(ws + W_DQKV), 1024, 384, lds);
  convert_matrix(tid__, bid__, p.w_dkv, (u16*)(ws + W_DQKV) + 384 * 1024, 1024, 320, lds);
  convert_matrix<true>(tid__, bid__, p.w_uq, (u16*)(ws + W_UQ), 384, 3072, lds);
  convert_matrix(tid__, bid__, p.w_ukv, (u16*)(ws + W_UKV), 256, 4096, lds);
  convert_matrix(tid__, bid__, p.w_o, (u16*)(ws + W_O), 2048, 1024, lds);
  convert_matrix(tid__, bid__, p.na_w_qkv, (u16*)(ws + W_NAQKV), 1024, 3072, lds);
  convert_matrix(tid__, bid__, p.na_w_o, (u16*)(ws + W_NAO), 1024, 1024, lds);
  convert_matrix(tid__, bid__, p.w1, (u16*)(ws + W_W1), 1024, 4096, lds, p.mlp_norm);
  convert_matrix(tid__, bid__, p.w1 + 1024 * 4096, (u16*)(ws + W_W1) + 4096 * 1024, 1024, 4096, lds, p.mlp_norm + DM);
  convert_matrix(tid__, bid__, p.w2, (u16*)(ws + W_W2), 4096, 1024, lds);
  convert_matrix(tid__, bid__, p.w2 + 1024 * 4096, (u16*)(ws + W_W2) + 4096 * 1024, 4096, 1024, lds);
  const int gt = bid__ * NTHR + tid__, gs = gridDim.x * NTHR;
  for (int i = gt; i < 8192; i += gs) ((u32x4*)((u16*)(ws + W_DQKV) + 704 * 1024))[i] = (u32x4){0u, 0u, 0u, 0u};
  for (int i = gt; i < TT; i += gs) ((float*)(ws + WS_SS))[i] = 0.f;
  float2* rope = (float2*)(ws + WS_ROPE);
  for (int i = gt; i < 16384 * 32; i += gs) {
    const int pos = i >> 5, k = i & 31;
    const double rev = (double)pos * c_inv[k] * 0.15915494309189535;
    const float f = (float)(rev - floor(rev));
    rope[i] = make_float2(__builtin_amdgcn_cosf(f), __builtin_amdgcn_sinf(f));
  }
}

DI void phase_rmsnorm_bf16(int tid__, int bid__, const float* src0, const float* src1, int split, const float* __restrict__ g, u16* __restrict__ H, float* zero_ss = nullptr) {
  const int wid = tid__ >> 6, lane = tid__ & 63;
  if (zero_ss) for (int i = bid__ * NTHR + tid__; i < TT; i += gridDim.x * NTHR) zero_ss[i] = 0.f;
  f32x4 gv[4];
#pragma unroll
  for (int i = 0; i < 4; ++i) gv[i] = *(const f32x4*)(g + lane * 4 + 256 * i);
  for (int row = (bid__ * 8 + wid) * 2; row < TT; row += gridDim.x * 16) {
    const float* x = row < split ? src0 + (long)row * DM : src1 + (long)(row - split) * DM;
    f32x4 v[4], w[4]; float ss = 0.f, st = 0.f;
#pragma unroll
    for (int i = 0; i < 4; ++i) { v[i] = *(const f32x4*)(x + lane * 4 + 256 * i); w[i] = *(const f32x4*)(x + DM + lane * 4 + 256 * i); }
#pragma unroll
    for (int i = 0; i < 4; ++i) { ss += v[i][0] * v[i][0] + v[i][1] * v[i][1] + v[i][2] * v[i][2] + v[i][3] * v[i][3]; st += w[i][0] * w[i][0] + w[i][1] * w[i][1] + w[i][2] * w[i][2] + w[i][3] * w[i][3]; }
    ss = wave_sum(ss); st = wave_sum(st);
    const float rs = rsqrtf(ss * (1.f / DM) + EPS), rt = rsqrtf(st * (1.f / DM) + EPS);
#pragma unroll
    for (int i = 0; i < 4; ++i) {
      u32x2 o; o[0] = cvtpk(v[i][0] * rs * gv[i][0], v[i][1] * rs * gv[i][1]); o[1] = cvtpk(v[i][2] * rs * gv[i][2], v[i][3] * rs * gv[i][3]);
      *(u32x2*)(H + (long)row * DM + lane * 4 + 256 * i) = o;
      u32x2 q; q[0] = cvtpk(w[i][0] * rt * gv[i][0], w[i][1] * rt * gv[i][1]); q[1] = cvtpk(w[i][2] * rt * gv[i][2], w[i][3] * rt * gv[i][3]);
      *(u32x2*)(H + (long)(row + 1) * DM + lane * 4 + 256 * i) = q;
    }
  }
}
DI void phase_rmsnorm_final(int tid__, int bid__, float* x, const float* __restrict__ g) {
  const int wid = tid__ >> 6, lane = tid__ & 63;
  f32x4 gv[4];
#pragma unroll
  for (int i = 0; i < 4; ++i) gv[i] = *(const f32x4*)(g + lane * 4 + 256 * i);
  for (int row = (bid__ * 8 + wid) * 2; row < TT; row += gridDim.x * 16) {
    float* xr = x + (long)row * DM;
    f32x4 v[4], w[4]; float ss = 0.f, st = 0.f;
#pragma unroll
    for (int i = 0; i < 4; ++i) { v[i] = *(const f32x4*)(xr + lane * 4 + 256 * i); w[i] = *(const f32x4*)(xr + DM + lane * 4 + 256 * i); }
#pragma unroll
    for (int i = 0; i < 4; ++i) { ss += v[i][0] * v[i][0] + v[i][1] * v[i][1] + v[i][2] * v[i][2] + v[i][3] * v[i][3]; st += w[i][0] * w[i][0] + w[i][1] * w[i][1] + w[i][2] * w[i][2] + w[i][3] * w[i][3]; }
    ss = wave_sum(ss); st = wave_sum(st);
    const float rs = rsqrtf(ss * (1.f / DM) + EPS), rt = rsqrtf(st * (1.f / DM) + EPS);
#pragma unroll
    for (int i = 0; i < 4; ++i) {
      f32x4 o; o[0] = v[i][0] * rs * gv[i][0]; o[1] = v[i][1] * rs * gv[i][1]; o[2] = v[i][2] * rs * gv[i][2]; o[3] = v[i][3] * rs * gv[i][3];
      *(f32x4*)(xr + lane * 4 + 256 * i) = o;
      f32x4 q; q[0] = w[i][0] * rt * gv[i][0]; q[1] = w[i][1] * rt * gv[i][1]; q[2] = w[i][2] * rt * gv[i][2]; q[3] = w[i][3] * rt * gv[i][3];
      *(f32x4*)(xr + DM + lane * 4 + 256 * i) = q;
    }
  }
}
DI void phase_lat_norm(int tid__, int bid__, const u16* __restrict__ CQKV, const float* __restrict__ qn, const float* __restrict__ kvn, const float2* __restrict__ rope,
                               u16* __restrict__ CQ, u16* __restrict__ CKV, u16* __restrict__ KR) {
  const int wid = tid__ >> 6, lane = tid__ & 63;
  constexpr int NR = 4;
  float gq[6], gk[4];
#pragma unroll
  for (int i = 0; i < 3; ++i) { gq[2 * i] = qn[lane * 2 + 128 * i]; gq[2 * i + 1] = qn[lane * 2 + 128 * i + 1]; }
#pragma unroll
  for (int i = 0; i < 2; ++i) { gk[2 * i] = kvn[lane * 2 + 128 * i]; gk[2 * i + 1] = kvn[lane * 2 + 128 * i + 1]; }
  for (int row0 = (bid__ * 8 + wid) * NR; row0 < TT; row0 += gridDim.x * 8 * NR) {
    unsigned q[NR][3], c[NR][2]; unsigned kru[NR]; float2 cs[NR];
#pragma unroll
    for (int r = 0; r < NR; ++r) {
      const u16* x = CQKV + (long)(row0 + r) * 768;
#pragma unroll
      for (int i = 0; i < 3; ++i) q[r][i] = *(const unsigned*)(x + lane * 2 + 128 * i);
#pragma unroll
      for (int i = 0; i < 2; ++i) c[r][i] = *(const unsigned*)(x + 384 + lane * 2 + 128 * i);
      kru[r] = x[640 + lane];
      cs[r] = rope[tok_pos(row0 + r) * 32 + (lane & 31)];
    }
#pragma unroll
    for (int r = 0; r < NR; ++r) {
      const int row = row0 + r;
      float sq = 0.f, sc = 0.f;
#pragma unroll
      for (int i = 0; i < 3; ++i) { const float a = bflo(q[r][i]), b = bfhi(q[r][i]); sq += a * a + b * b; }
#pragma unroll
      for (int i = 0; i < 2; ++i) { const float a = bflo(c[r][i]), b = bfhi(c[r][i]); sc += a * a + b * b; }
      const float kr = __uint_as_float(kru[r] << 16);
      sq = wave_sum(sq); sc = wave_sum(sc);
      const float rq = rsqrtf(sq * (1.f / 384.f) + EPS), rc = rsqrtf(sc * (1.f / 256.f) + EPS);
#pragma unroll
      for (int i = 0; i < 3; ++i) { const int e = lane * 2 + 128 * i; *(unsigned*)(CQ + (long)row * 384 + e) = cvtpk(bflo(q[r][i]) * rq * gq[2 * i], bfhi(q[r][i]) * rq * gq[2 * i + 1]); }
#pragma unroll
      for (int i = 0; i < 2; ++i) { const int e = lane * 2 + 128 * i; *(unsigned*)(CKV + (long)row * 256 + e) = cvtpk(bflo(c[r][i]) * rc * gk[2 * i], bfhi(c[r][i]) * rc * gk[2 * i + 1]); }
      float other;
      { auto rr = __builtin_amdgcn_permlane32_swap(__float_as_uint(kr), __float_as_uint(kr), false, false); other = __uint_as_float(lane < 32 ? rr[1] : rr[0]); }
      const float o = lane < 32 ? kr * cs[r].x - other * cs[r].y : other * cs[r].y + kr * cs[r].x;
      KR[(long)row * 64 + 2 * (lane & 31) + (lane >> 5)] = (u16)(cvtpk(o, 0.f) & 0xffffu);
    }
  }
}

namespace pg8 {
#define PG8_LAS __attribute__((address_space(3)))
typedef unsigned short bf16_t;
typedef short bf16x8 __attribute__((ext_vector_type(8)));
typedef float f32x4 __attribute__((ext_vector_type(4)));
typedef unsigned u32x4 __attribute__((ext_vector_type(4)));
constexpr int BM = 256, BK = 64, HALF = 128, HTB = HALF * BK * 2  , STAGE_BYTES = 8 * HTB, NXCD = 8, WGM = 8;

__host__ __device__ __forceinline__ int lds_byte(int r, int c) { const int st = (r >> 4) * 2 + (c >> 5), rr = r & 15, cc = c & 31, ob = rr * 64 + cc * 2; return st * 1024 + (ob ^ (((ob >> 9) & 1) << 5)); }
__host__ __device__ __forceinline__ void stage_rc(int b, int& R, int& C) { const int st = b / 1024, sb = b % 1024, swz = sb ^ (((sb >> 9) & 1) << 5); R = (st >> 1) * 16 + swz / 64; C = (st & 1) * 32 + (swz % 64) / 2; }
__host__ __device__ __forceinline__ int perm32(int rho) { const int n = rho >> 4, i = rho & 15; return 8 * (i >> 2) + 4 * n + (i & 3); }

struct Unit { int pm, pn; };
struct Gemm { const bf16_t* A; const bf16_t* Bt; int M, N, K; };

struct StaticOrder {
    int nM, nN, nwg, G, c;
    __host__ __device__ void init(int M, int N, int G_, int c_) { nM = M / BM; nN = N / BM; nwg = nM * nN; G = G_; c = c_; }
    __host__ __device__ bool next(int i, Unit& u) const {
        const long L = (long)i * G + c; if (L >= nwg) return false;
        int wgid = (int)L; { const int q = nwg / NXCD, r = nwg % NXCD, xcd = wgid % NXCD, off = wgid / NXCD; wgid = (xcd < r ? xcd * (q + 1) : r * (q + 1) + (xcd - r) * q) + off; }
        const int nig = WGM * nN, gid = wgid / nig, fm = gid * WGM, gsz = (nM - fm) < WGM ? (nM - fm) : WGM;
        u.pm = fm + ((wgid % nig) % gsz); u.pn = (wgid % nig) / gsz; return true;
    }
    __device__ __forceinline__ void a_ready(const Unit&) const {}
    __device__ __forceinline__ void done(const Unit&) const {}
};

__device__ __forceinline__ unsigned cvt_pk_bf16(float lo, float hi) { unsigned r; asm volatile("v_cvt_pk_bf16_f32 %0, %1, %2" : "=v"(r) : "v"(lo), "v"(hi)); return r; }
__device__ __forceinline__ unsigned long long wall_clock64_() { return 0ull; }
template <int ACT> struct EpiBf16 {
    static constexpr bool PERM = true, AFTER_DRAIN = false;
    bf16_t* O; int ldc; const float* ss;
    __device__ __forceinline__ void operator()(const f32x4 (&acc)[2][2][4][2], const Unit& u, int wr, int wc, int fr, int fq) const {
        const int row0 = u.pm * BM + wr * 64 + fr, col0 = u.pn * BM + wc * 32 + 8 * fq;
#pragma unroll
        for (int ai = 0; ai < 2; ++ai)
#pragma unroll
            for (int m = 0; m < 4; ++m) { bf16_t* rowp = O + (size_t)(row0 + ai * HALF + m * 16) * ldc + col0;
                float rs2 = 1.f; if (ACT == 1) rs2 = __builtin_amdgcn_rcpf(ss[row0 + ai * HALF + m * 16] * (1.f / 1024.f) + 1e-6f);
#pragma unroll
                for (int bj = 0; bj < 2; ++bj) { f32x4 v0 = acc[ai][bj][m][0], v1 = acc[ai][bj][m][1];
                    if (ACT == 1) {
#pragma unroll
                        for (int j = 0; j < 4; ++j) { const float a = fmaxf(v0[j], 0.f), b = fmaxf(v1[j], 0.f); v0[j] = a * a * rs2; v1[j] = b * b * rs2; } }
                    u32x4 w; w.x = cvt_pk_bf16(v0[0], v0[1]); w.y = cvt_pk_bf16(v0[2], v0[3]); w.z = cvt_pk_bf16(v1[0], v1[1]); w.w = cvt_pk_bf16(v1[2], v1[3]);
                    *(u32x4*)(rowp + bj * HALF) = w; } }
    }
};
struct EpiQRope {
    static constexpr bool PERM = true, AFTER_DRAIN = false;
    bf16_t* O; int ldc; const float* rope; int grow0; float qs;
    __device__ __forceinline__ void operator()(const f32x4 (&acc)[2][2][4][2], const Unit& u, int wr, int wc, int fr, int fq) const {
        const int row0 = u.pm * BM + wr * 64 + fr, colw = u.pn * BM + wc * 32, col0 = colw + 8 * fq;
#pragma unroll
        for (int ai = 0; ai < 2; ++ai)
#pragma unroll
            for (int m = 0; m < 4; ++m) { const int row = row0 + ai * HALF + m * 16; bf16_t* rowp = O + (size_t)row * ldc + col0;
                const int g = grow0 + row, pos = g < 32768 ? (g & 16383) : ((g - 32768) & 4095);
#pragma unroll
                for (int bj = 0; bj < 2; ++bj) { f32x4 v0 = acc[ai][bj][m][0], v1 = acc[ai][bj][m][1];
                    const int hcw = (colw + bj * HALF) % 192;
                    if (hcw >= 128) {
                        const float* rp = rope + ((size_t)pos * 32 + ((hcw - 128) >> 1) + 4 * fq) * 2;
                        const f32x4 c0 = *(const f32x4*)rp, c1 = *(const f32x4*)(rp + 4);
                        f32x4 r0, r1;
                        r0[0] = v0[0] * c0[0] - v0[1] * c0[1]; r0[1] = v0[0] * c0[1] + v0[1] * c0[0];
                        r0[2] = v0[2] * c0[2] - v0[3] * c0[3]; r0[3] = v0[2] * c0[3] + v0[3] * c0[2];
                        r1[0] = v1[0] * c1[0] - v1[1] * c1[1]; r1[1] = v1[0] * c1[1] + v1[1] * c1[0];
                        r1[2] = v1[2] * c1[2] - v1[3] * c1[3]; r1[3] = v1[2] * c1[3] + v1[3] * c1[2];
                        v0 = r0; v1 = r1;
                    }
                    v0 *= qs; v1 *= qs;
                    u32x4 w; w.x = cvt_pk_bf16(v0[0], v0[1]); w.y = cvt_pk_bf16(v0[2], v0[3]); w.z = cvt_pk_bf16(v1[0], v1[1]); w.w = cvt_pk_bf16(v1[2], v1[3]);
                    *(u32x4*)(rowp + bj * HALF) = w; } }
    }
};
template <bool STATS> struct EpiResid {
    static constexpr bool PERM = false, AFTER_DRAIN = false;
    float* C; const float* R; int ldc; bf16_t* XB; float* ss;
    __device__ __forceinline__ void operator()(const f32x4 (&acc)[2][2][4][2], const Unit& u, int wr, int wc, int fr, int fq) const {
        const int row0 = u.pm * BM + wr * 64 + fr, col0 = u.pn * BM + wc * 32 + 4 * fq;
#pragma unroll
        for (int ai = 0; ai < 2; ++ai)
#pragma unroll
            for (int m = 0; m < 4; ++m) { const int row = row0 + ai * HALF + m * 16; const size_t ro = (size_t)row * ldc + col0; float s = 0.f;
#pragma unroll
                for (int bj = 0; bj < 2; ++bj)
#pragma unroll
                    for (int n = 0; n < 2; ++n) { const f32x4 r = *(const f32x4*)(R + ro + bj * HALF + n * 16); const f32x4 y = acc[ai][bj][m][n] + r; *(f32x4*)(C + ro + bj * HALF + n * 16) = y;
                        if (STATS) { s += y[0] * y[0] + y[1] * y[1] + y[2] * y[2] + y[3] * y[3];
                            unsigned w0 = cvt_pk_bf16(y[0], y[1]), w1 = cvt_pk_bf16(y[2], y[3]);
                            *(unsigned long long*)(XB + (size_t)row * 1024 + col0 + bj * HALF + n * 16) = (unsigned long long)w0 | ((unsigned long long)w1 << 32); } }
                if (STATS) {
                    s += __int_as_float(__builtin_amdgcn_ds_swizzle(__float_as_int(s), (16 << 10) | 0x1f));
                    auto rr = __builtin_amdgcn_permlane32_swap(__float_as_uint(s), __float_as_uint(s), false, false);
                    s = __uint_as_float(rr[0]) + __uint_as_float(rr[1]);
                    if (fq == 0) atomicAdd(ss + row, s);
                } }
    }
};

template <class Epi, class Sched>
__device__ __forceinline__ void gemm_phase(const int tid, PG8_LAS unsigned char* lds, const Gemm g, const Sched& S, const Epi& E) {
    constexpr bool STAMP = false; unsigned long long* stamps = nullptr;
    const int wid = __builtin_amdgcn_readfirstlane(tid >> 6), lane = tid & 63, wr = wid >> 2, wc = wid & 3, fr = lane & 15, fq = lane >> 4;
    const int K = g.K, nt = K / BK;
    int ts_lo = 0, ts_hi = 0, nts = 0; const unsigned long long rt_entry = STAMP ? (unsigned long long)wall_clock64_() : 0ull;
#define PG8_STAMP() do { if (STAMP && wid == 0 && nts < 64) { const unsigned long long _c = (unsigned long long)clock64(); \
        ts_lo = (lane == nts) ? (int)(unsigned)_c : ts_lo; ts_hi = (lane == nts) ? (int)(unsigned)(_c >> 32) : ts_hi; ++nts; } } while (0)
    PG8_STAMP();
    unsigned voffA[2], voffB[2];
#pragma unroll
    for (int i = 0; i < 2; ++i) { int R, C; stage_rc(tid * 16 + i * 8192, R, C); const int Rb = Epi::PERM ? ((R & ~31) + perm32(R & 31)) : R;
        voffA[i] = (unsigned)(R * K + C) * 2u; voffB[i] = (unsigned)(Rb * K + C) * 2u; }
    const size_t kstep = (size_t)(BK * 2);
    const size_t hstep = (size_t)HALF * K * 2;
    const size_t tstep = 2 * hstep;
    const unsigned ldsw = (unsigned)wid * 1024u;
    const int aoff = lds_byte(wr * 64 + fr, fq * 8), boff = lds_byte(wc * 32 + fr, fq * 8);
#define PG8_SA(b, h) (((b) * 2 + (h)) * HTB)
#define PG8_SB(b, h) ((4 + (b) * 2 + (h)) * HTB)
#define PG8_STAGE(bufoff, gbase, voff) do { _Pragma("unroll") for (int _i = 0; _i < 2; ++_i) \
        __builtin_amdgcn_global_load_lds((const unsigned*)((const char*)(gbase) + (voff)[_i]), (PG8_LAS unsigned*)(lds + (bufoff) + ldsw + _i * 8192), 16, 0, 0); } while (0)
#define PG8_LDA(dst, b, h) do { _Pragma("unroll") for (int m = 0; m < 4; ++m) _Pragma("unroll") for (int k = 0; k < 2; ++k) dst[m][k] = *(const PG8_LAS bf16x8*)(lds + PG8_SA(b, h) + aoff + m * 2048 + k * 1024); } while (0)
#define PG8_LDB(dst, b, h) do { _Pragma("unroll") for (int n = 0; n < 2; ++n) _Pragma("unroll") for (int k = 0; k < 2; ++k) dst[n][k] = *(const PG8_LAS bf16x8*)(lds + PG8_SB(b, h) + boff + n * 2048 + k * 1024); } while (0)
#define PG8_MMA(ai, bj, At, Bt) do { __builtin_amdgcn_s_setprio(1); _Pragma("unroll") for (int m = 0; m < 4; ++m) _Pragma("unroll") for (int n = 0; n < 2; ++n) _Pragma("unroll") for (int k = 0; k < 2; ++k) \
        acc[ai][bj][m][n] = __builtin_amdgcn_mfma_f32_16x16x32_bf16(Bt[n][k], At[m][k], acc[ai][bj][m][n], 0, 0, 0); __builtin_amdgcn_s_setprio(0); } while (0)
#define PG8_WAIT_V(n) asm volatile("s_waitcnt vmcnt(" #n ")" ::: "memory")
#define PG8_WAIT_L(n) asm volatile("s_waitcnt lgkmcnt(" #n ")" ::: "memory")
#define PG8_BAR __builtin_amdgcn_s_barrier()
#define PG8_SCHED __builtin_amdgcn_sched_barrier(0)
    Unit cur, nxt; int ui = 0;
    if (!S.next(0, cur)) return;
    f32x4 acc[2][2][4][2];
#pragma unroll
    for (int a = 0; a < 2; ++a)
#pragma unroll
        for (int b = 0; b < 2; ++b)
#pragma unroll
            for (int m = 0; m < 4; ++m)
#pragma unroll
                for (int n = 0; n < 2; ++n) acc[a][b][m][n] = (f32x4){0.f, 0.f, 0.f, 0.f};
    bf16x8 At[4][2], B0[2][2], B1[2][2];
    const char* cA = (const char*)g.A + (size_t)cur.pm * tstep; const char* cB = (const char*)g.Bt + (size_t)cur.pn * tstep;
    S.a_ready(cur);
    PG8_STAGE(PG8_SB(0, 0), cB, voffB); PG8_STAGE(PG8_SA(0, 0), cA, voffA); PG8_STAGE(PG8_SB(0, 1), cB + hstep, voffB); PG8_STAGE(PG8_SA(0, 1), cA + hstep, voffA);
    if (wr == 1) PG8_BAR;
    PG8_WAIT_V(4); PG8_BAR;
    PG8_STAGE(PG8_SB(1, 0), cB + kstep, voffB); PG8_STAGE(PG8_SA(1, 0), cA + kstep, voffA); PG8_STAGE(PG8_SB(1, 1), cB + hstep + kstep, voffB);
    PG8_WAIT_V(6); PG8_BAR;
    PG8_STAMP();
    for (;;) {
        const bool has_next = S.next(ui + 1, nxt);
        const char* nA = has_next ? (const char*)g.A + (size_t)nxt.pm * tstep : cA; const char* nB = has_next ? (const char*)g.Bt + (size_t)nxt.pn * tstep : cB;
        for (int t = 0; t < nt; t += 2) {
            const bool last = (t == nt - 2);
            const char* a1 = cA + (size_t)(t + 1) * kstep;
            const char* a2 = last ? nA : cA + (size_t)(t + 2) * kstep; const char* b2 = last ? nB : cB + (size_t)(t + 2) * kstep;
            const char* a3 = a2 + kstep; const char* b3 = b2 + kstep;
            if (last && has_next) S.a_ready(nxt);
            PG8_LDB(B0, 0, 0); PG8_SCHED; PG8_LDA(At, 0, 0); PG8_STAGE(PG8_SA(1, 1), a1 + hstep, voffA);
            PG8_WAIT_L(8); PG8_BAR; PG8_WAIT_L(0); PG8_MMA(0, 0, At, B0); PG8_BAR; PG8_SCHED;
            PG8_LDB(B1, 0, 1); PG8_STAGE(PG8_SB(0, 0), b2, voffB);
            PG8_BAR; PG8_WAIT_L(0); PG8_MMA(0, 1, At, B1); PG8_BAR;
            PG8_LDA(At, 0, 1); PG8_STAGE(PG8_SA(0, 0), a2, voffA);
            PG8_BAR; PG8_WAIT_L(0); PG8_MMA(1, 0, At, B0); PG8_BAR; PG8_SCHED;
            PG8_STAGE(PG8_SB(0, 1), b2 + hstep, voffB);
            PG8_WAIT_V(6); PG8_BAR; PG8_MMA(1, 1, At, B1); PG8_BAR;
            PG8_LDB(B0, 1, 0); PG8_SCHED; PG8_LDA(At, 1, 0); PG8_STAGE(PG8_SA(0, 1), a2 + hstep, voffA);
            PG8_WAIT_L(8); PG8_BAR; PG8_WAIT_L(0); PG8_MMA(0, 0, At, B0); PG8_BAR; PG8_SCHED;
            PG8_LDB(B1, 1, 1); PG8_STAGE(PG8_SB(1, 0), b3, voffB);
            PG8_BAR; PG8_WAIT_L(0); PG8_MMA(0, 1, At, B1); PG8_BAR;
            PG8_LDA(At, 1, 1); PG8_STAGE(PG8_SA(1, 0), a3, voffA);
            PG8_BAR; PG8_WAIT_L(0); PG8_MMA(1, 0, At, B0); PG8_BAR; PG8_SCHED;
            PG8_STAGE(PG8_SB(1, 1), b3 + hstep, voffB);
            PG8_WAIT_V(6); PG8_BAR; PG8_MMA(1, 1, At, B1); PG8_BAR;
        }
        PG8_STAMP();
        if constexpr (!Epi::AFTER_DRAIN) { E(acc, cur, wr, wc, fr, fq); S.done(cur); }
        PG8_STAMP();
        if (!has_next) break;
#pragma unroll
        for (int a = 0; a < 2; ++a)
#pragma unroll
            for (int b = 0; b < 2; ++b)
#pragma unroll
                for (int m = 0; m < 4; ++m)
#pragma unroll
                    for (int n = 0; n < 2; ++n) acc[a][b][m][n] = (f32x4){0.f, 0.f, 0.f, 0.f};
        cur = nxt; cA = nA; cB = nB; ++ui;
    }
    PG8_WAIT_V(0);
    if (wr == 0) PG8_BAR;
    PG8_BAR;
    if constexpr (Epi::AFTER_DRAIN) { E.fused(acc, cur, wr, wc, fr, fq, lds, wid, lane); S.done(cur); }
    PG8_STAMP();
    if (STAMP && wid == 0) { stamps[lane] = lane < nts ? (((unsigned long long)(unsigned)ts_hi << 32) | (unsigned)ts_lo) : 0ull;
        if (lane == 62) stamps[62] = rt_entry; if (lane == 63) stamps[63] = (unsigned long long)wall_clock64_(); }
#undef PG8_STAMP
#undef PG8_SA
#undef PG8_SB
#undef PG8_STAGE
#undef PG8_LDA
#undef PG8_LDB
#undef PG8_MMA
#undef PG8_WAIT_V
#undef PG8_WAIT_L
#undef PG8_BAR
#undef PG8_SCHED
}
}

constexpr float ATT_SCALE = 0.07216878364870323f;
constexpr float ATT_THR = 8.f;
constexpr int SHM_V = 16384, SHM_K = 24576;
constexpr int LDQ = 3072, LDKV = 4096, LDO = 2048;

template <bool NA = false>
DI void partialSM(f32x16& p0, f32x16& p1, float& m_reg, float& mn, float& alpha) {
  constexpr float C = (NA ? 1.f : ATT_SCALE) * 1.4426950408889634f;
  float pmax = p0[0];
#pragma unroll
  for (int r = 1; r < 16; ++r) pmax = fmaxf(pmax, p0[r]);
#pragma unroll
  for (int r = 0; r < 16; ++r) pmax = fmaxf(pmax, p1[r]);
  { auto rr = __builtin_amdgcn_permlane32_swap(__float_as_uint(pmax), __float_as_uint(pmax), false, false);
    pmax = fmaxf(__uint_as_float(rr[0]), __uint_as_float(rr[1])); }
  if (__builtin_expect(__all(pmax - m_reg <= ATT_THR / (NA ? 1.f : ATT_SCALE)), 1)) { mn = m_reg; alpha = 1.f; }
  else { mn = fmaxf(m_reg, pmax); alpha = __builtin_amdgcn_exp2f((m_reg - mn) * C); m_reg = mn; }
  const float mnC = -mn * C;
#pragma unroll
  for (int r = 0; r < 16; ++r) p0[r] = fmaf(p0[r], C, mnC);
#pragma unroll
  for (int r = 0; r < 16; ++r) p1[r] = fmaf(p1[r], C, mnC);
#pragma unroll
  for (int r = 0; r < 16; ++r) p0[r] = __builtin_amdgcn_exp2f(p0[r]);
}
DI void finishSM(f32x16& p0, f32x16& p1, float alpha, float& l_reg, bf16x8& pa0, bf16x8& pa1, bf16x8& pa2, bf16x8& pa3) {
#pragma unroll
  for (int r = 0; r < 16; ++r) p1[r] = __builtin_amdgcn_exp2f(p1[r]);
  float ps = 0;
#pragma unroll
  for (int r = 0; r < 16; ++r) ps += p0[r];
#pragma unroll
  for (int r = 0; r < 16; ++r) ps += p1[r];
  { auto rr = __builtin_amdgcn_permlane32_swap(__float_as_uint(ps), __float_as_uint(ps), false, false);
    ps = __uint_as_float(rr[0]) + __uint_as_float(rr[1]); }
  l_reg = l_reg * alpha + ps;
#define PK4(P, BASE, OUT) do { unsigned a0 = cvtpk(P[BASE + 0], P[BASE + 1]), a1 = cvtpk(P[BASE + 2], P[BASE + 3]);   \
    unsigned b0 = cvtpk(P[BASE + 4], P[BASE + 5]), b1 = cvtpk(P[BASE + 6], P[BASE + 7]);                              \
    auto r0 = __builtin_amdgcn_permlane32_swap(a0, b0, false, false); auto r1 = __builtin_amdgcn_permlane32_swap(a1, b1, false, false); \
    u32x4 w = {r0[0], r1[0], r0[1], r1[1]}; OUT = __builtin_bit_cast(bf16x8, w); } while (0)
  PK4(p0, 0, pa0); PK4(p0, 8, pa1); PK4(p1, 0, pa2); PK4(p1, 8, pa3);
#undef PK4
}
DI void qkt(f32x16& p0, f32x16& p1, const char* Ks, const bf16x8* qr, const char* Qs, int k0, int k1, int k2, int k3) {
#pragma unroll
  for (int r = 0; r < 16; ++r) { p0[r] = 0.f; p1[r] = 0.f; }
#pragma unroll
  for (int d0 = 0; d0 < 12; ++d0) {
    const int off = ((d0 & 3) == 0 ? k0 : (d0 & 3) == 1 ? k1 : (d0 & 3) == 2 ? k2 : k3) + (d0 >> 2) * 128;
    const bf16x8 b0 = *(const bf16x8*)(Ks + off);
    const bf16x8 b1 = *(const bf16x8*)(Ks + off + 32 * 384);
    const bf16x8 qv = d0 < 8 ? qr[d0 & 7] : *(const bf16x8*)(Qs + (d0 - 8) * 1024);
    p0 = MFMA32(b0, qv, p0);
    p1 = MFMA32(b1, qv, p1);
  }
}
DI int v_st(int k, int c) { const int kk = (k & ~0xC) | ((k & 4) << 1) | ((k & 8) >> 1); return ((kk >> 3) * 4 + (c >> 5)) * 512 + ((kk & 7) * 32 + (c & 31)) * 2; }
DI int v_rd_base(int lane) { return ((lane & 3) << 3) | (((lane >> 2) & 3) << 6) | (((lane >> 4) & 1) << 5) | (((lane >> 5) & 1) << 8); }
constexpr int v_rd_off(int d0, int ks, int half) { return d0 * 512 + ks * 4096 + half * 2048; }
template <int OFF> DI s16x4 tr_read(int vb) {
  s16x4 r; asm volatile("ds_read_b64_tr_b16 %0, %1 offset:%2" : "=&v"(r) : "v"(vb), "i"(OFF) : "memory"); return r;
}
template <int D0> DI void pv_one(f32x16& od, int vb, bf16x8 pa0, bf16x8 pa1, bf16x8 pa2, bf16x8 pa3) {
  const s16x4 l0 = tr_read<v_rd_off(D0, 0, 0)>(vb), h0 = tr_read<v_rd_off(D0, 0, 1)>(vb), l1 = tr_read<v_rd_off(D0, 1, 0)>(vb), h1 = tr_read<v_rd_off(D0, 1, 1)>(vb);
  const s16x4 l2 = tr_read<v_rd_off(D0, 2, 0)>(vb), h2 = tr_read<v_rd_off(D0, 2, 1)>(vb), l3 = tr_read<v_rd_off(D0, 3, 0)>(vb), h3 = tr_read<v_rd_off(D0, 3, 1)>(vb);
  asm volatile("s_waitcnt lgkmcnt(0)" ::: "memory"); SBAR();
#define PK(L, H) (bf16x8){L[0], L[1], L[2], L[3], H[0], H[1], H[2], H[3]}
  od = MFMA32(pa0, PK(l0, h0), od);
  od = MFMA32(pa1, PK(l1, h1), od);
  od = MFMA32(pa2, PK(l2, h2), od);
  od = MFMA32(pa3, PK(l3, h3), od);
#undef PK
}
DI void pv_d0(f32x16* o, int vb, bf16x8 pa0, bf16x8 pa1, bf16x8 pa2, bf16x8 pa3) {
  pv_one<0>(o[0], vb, pa0, pa1, pa2, pa3); pv_one<1>(o[1], vb, pa0, pa1, pa2, pa3); pv_one<2>(o[2], vb, pa0, pa1, pa2, pa3); pv_one<3>(o[3], vb, pa0, pa1, pa2, pa3);
}

template <int H> DI void qkt_half(f32x16& p0, f32x16& p1, const char* Ks, const bf16x8* qr, const char* Qs, int k0, int k1, int k2, int k3, float negm = 0.f) {
  if (H == 0) {
#pragma unroll
    for (int r = 0; r < 16; ++r) { p0[r] = negm; p1[r] = negm; }
  }
#pragma unroll
  for (int d0 = 6 * H; d0 < 6 * H + 6; ++d0) {
    const int off = ((d0 & 3) == 0 ? k0 : (d0 & 3) == 1 ? k1 : (d0 & 3) == 2 ? k2 : k3) + (d0 >> 2) * 128;
    const bf16x8 b0 = *(const bf16x8*)(Ks + off);
    const bf16x8 b1 = *(const bf16x8*)(Ks + off + 32 * 384);
    const bf16x8 qv = d0 < 8 ? qr[d0 & 7] : *(const bf16x8*)(Qs + (d0 - 8) * 1024);
    p0 = MFMA32(b0, qv, p0);
    p1 = MFMA32(b1, qv, p1);
  }
}
template <bool P0HI = false>
DI void finish_part(f32x16& p0, f32x16& p1, float alpha, float& l_reg) {
  if (P0HI) {
#pragma unroll
    for (int r = 0; r < 16; ++r) p0[r] = __builtin_amdgcn_exp2f(p0[r]);
  }
#pragma unroll
  for (int r = 0; r < 16; ++r) p1[r] = __builtin_amdgcn_exp2f(p1[r]);
  float ps = 0;
#pragma unroll
  for (int r = 0; r < 16; ++r) ps += p0[r];
#pragma unroll
  for (int r = 0; r < 16; ++r) ps += p1[r];
  { auto rr = __builtin_amdgcn_permlane32_swap(__float_as_uint(ps), __float_as_uint(ps), false, false);
    ps = __uint_as_float(rr[0]) + __uint_as_float(rr[1]); }
  l_reg = l_reg * alpha + ps;
}
template <int BASE> DI bf16x8 pack8(const f32x16& P) {
  u32x4 w = {cvtpk(P[BASE + 0], P[BASE + 1]), cvtpk(P[BASE + 2], P[BASE + 3]), cvtpk(P[BASE + 4], P[BASE + 5]), cvtpk(P[BASE + 6], P[BASE + 7])};
  return __builtin_bit_cast(bf16x8, w);
}
DI float sm_max(const f32x16& p0, const f32x16& p1) {
  float pmax = p0[0];
#pragma unroll
  for (int r = 1; r < 16; ++r) pmax = fmaxf(pmax, p0[r]);
#pragma unroll
  for (int r = 0; r < 16; ++r) pmax = fmaxf(pmax, p1[r]);
  auto rr = __builtin_amdgcn_permlane32_swap(__float_as_uint(pmax), __float_as_uint(pmax), false, false);
  return fmaxf(__uint_as_float(rr[0]), __uint_as_float(rr[1]));
}
constexpr float ATT_C = ATT_SCALE * 1.4426950408889634f;
constexpr float ATT_THR2 = ATT_THR * 1.4426950408889634f;
DI void sm_decide2(float pmax, float& m2, float& alpha, f32x16& p0, f32x16& p1) {
  alpha = 1.f;
  if (__builtin_expect(!__all(pmax <= ATT_THR2), 0)) {
    const float shift = fmaxf(pmax, 0.f);
#pragma unroll
    for (int r = 0; r < 16; ++r) { p0[r] -= shift; p1[r] -= shift; }
    alpha = __builtin_amdgcn_exp2f(-shift); m2 += shift;
  }
}
template <int LO> DI void sm_exp8(f32x16& p) {
#pragma unroll
  for (int r = LO; r < LO + 8; ++r) p[r] = __builtin_amdgcn_exp2f(p[r]);
}

constexpr int ATT_VOFF = 0, ATT_KOFF = 3 * SHM_V, ATT_WOFF = ATT_KOFF + 2 * SHM_K, ATT_QOFF = ATT_WOFF + 2048, ATT_LDS_END = ATT_QOFF + 32768;
static_assert(ATT_LDS_END <= LDS_BYTES, "attention LDS");
#define LAS3 __attribute__((address_space(3)))
DI void attn_tile(int tid__, int bid__, const u16* __restrict__ Qb, const u16* __restrict__ Kh, const u16* __restrict__ Vh, const u16* __restrict__ KRb, u16* __restrict__ Ob, int seq, char* lds) {
  const int tid = tid__, wid = __builtin_amdgcn_readfirstlane(tid >> 6), lane = tid & 63, r32 = lane & 31, hi = lane >> 5;
  char* V_lds = lds + ATT_VOFF; char* K_lds = lds + ATT_KOFF;
  float* wsf = (float*)(lds + ATT_WOFF) + wid * 64; float* li_l = wsf; float* al_l = wsf + 32;
  float m_reg = -1e30f, l_reg = 0; f32x16 o[4]; bf16x8 qr[8];
#pragma unroll
  for (int d = 0; d < 4; ++d)
#pragma unroll
    for (int r = 0; r < 16; ++r) o[d][r] = 0.f;
  const u16* Qw = Qb + (long)(wid * 32 + r32) * LDQ + hi * 8;
  char* Qs = lds + ATT_QOFF + wid * 4096 + lane * 16;
  const char* const kbase = (const char*)KRb; const unsigned dK = (unsigned)((const char*)Kh - (const char*)KRb);
  const char* vbase = (const char*)Vh;
  unsigned ko0, ko1, ko2, kstp0, kstp1, kstp2;
#define KSRC(i, KO, KS) do { const int p_ = (i) * 512 + tid, row_ = p_ / 24, cpos_ = p_ - row_ * 24, c_ = (cpos_ & ~7) | ((cpos_ & 7) ^ ((row_ >> 1) & 7)); \
    const bool np_ = cpos_ < 16; KO = np_ ? dK + (unsigned)(row_ * (LDKV * 2) + c_ * 16) : (unsigned)(row_ * 128 + (c_ - 16) * 16); KS = np_ ? 64u * LDKV * 2u : 64u * 64u * 2u; } while (0)
  KSRC(0, ko0, kstp0); KSRC(1, ko1, kstp1); KSRC(2, ko2, kstp2);
#undef KSRC
  unsigned vo0;
#define VSRC(i, VO) do { const int p_ = (i) * 512 + tid, kk_ = ((p_ >> 7) << 3) | ((p_ >> 2) & 7), k_ = kk_  , c_ = (((p_ >> 5) & 3) << 5) | ((p_ & 3) << 3); \
    VO = (unsigned)(k_ * (LDKV * 2) + c_ * 2); } while (0)
  VSRC(0, vo0);
#undef VSRC
  const int vb0 = (int)(uintptr_t)V_lds + v_rd_base(lane);
  const int xs = ((r32 >> 1) & 7) << 4, kb = r32 * 384;
  const int k0 = kb + ((hi * 16) ^ xs), k1 = kb + ((32 + hi * 16) ^ xs), k2 = kb + ((64 + hi * 16) ^ xs), k3 = kb + ((96 + hi * 16) ^ xs);
  LAS3 char* const ldsK = (LAS3 char*)lds + ATT_KOFF + wid * 1024; LAS3 char* const ldsV = (LAS3 char*)lds + ATT_VOFF + wid * 1024;
#define DMA(kb_, vo_) do { \
    __builtin_amdgcn_global_load_lds((const unsigned*)(kbase + ko0), (LAS3 unsigned*)(ldsK + (kb_) * SHM_K), 16, 0, 0); \
    __builtin_amdgcn_global_load_lds((const unsigned*)(kbase + ko1), (LAS3 unsigned*)(ldsK + (kb_) * SHM_K + 8192), 16, 0, 0); \
    __builtin_amdgcn_global_load_lds((const unsigned*)(kbase + ko2), (LAS3 unsigned*)(ldsK + (kb_) * SHM_K + 16384), 16, 0, 0); \
    __builtin_amdgcn_global_load_lds((const unsigned*)(vbase + vo0), (LAS3 unsigned*)(ldsV + (vo_)), 16, 0, 0); \
    __builtin_amdgcn_global_load_lds((const unsigned*)(vbase + 32 * LDKV * 2 + vo0), (LAS3 unsigned*)(ldsV + (vo_) + 8192), 16, 0, 0); \
    ko0 += kstp0; ko1 += kstp1; ko2 += kstp2; vbase += 64 * LDKV * 2; } while (0)
#define VNEXT(x) do { x += SHM_V; if (x == 3 * SHM_V) x = 0; } while (0)
#define STEP_END() do { asm volatile("s_waitcnt vmcnt(0)" ::: "memory"); __syncthreads(); } while (0)
#define RESC(a) do { if (__any((a) < 1.f)) { _Pragma("unroll") for (int d = 0; d < 4; ++d) _Pragma("unroll") for (int r = 0; r < 16; ++r) o[d][r] *= (a); } } while (0)
  f32x16 pA0, pA1, pB0, pB1; float mnA, mnB, alA, alB; bf16x8 pa0, pa1, pa2, pa3; const int NT = seq / 64;
  asm volatile("s_waitcnt vmcnt(0)" ::: "memory");
  __syncthreads();
  int vwr = 0, vrd = 0;
  DMA(0, vwr); VNEXT(vwr);
  DMA(1, vwr); VNEXT(vwr);
#pragma unroll
  for (int d0 = 0; d0 < 8; ++d0) qr[d0] = *(const bf16x8*)(Qw + d0 * 16);
  {
    bf16x8 qx[4];
#pragma unroll
    for (int i = 0; i < 4; ++i) qx[i] = *(const bf16x8*)(Qw + 128 + i * 16);
    asm volatile("s_waitcnt vmcnt(0)" ::: "memory");
#pragma unroll
    for (int i = 0; i < 4; ++i) *(bf16x8*)(Qs + i * 1024) = qx[i];
  }
  __syncthreads();
  qkt_half<0>(pA0, pA1, K_lds, qr, Qs, k0, k1, k2, k3); qkt_half<1>(pA0, pA1, K_lds, qr, Qs, k0, k1, k2, k3);
  { m_reg = sm_max(pA0, pA1);
#pragma unroll
    for (int r = 0; r < 16; ++r) { pA0[r] -= m_reg; pA1[r] -= m_reg; }
    alA = 1.f; }
  STEP_END();
#define PV_READS(KS) const s16x4 l0_ = tr_read<v_rd_off(0, KS, 0)>(vbv), h0_ = tr_read<v_rd_off(0, KS, 1)>(vbv), l1_ = tr_read<v_rd_off(1, KS, 0)>(vbv), h1_ = tr_read<v_rd_off(1, KS, 1)>(vbv), \
    l2_ = tr_read<v_rd_off(2, KS, 0)>(vbv), h2_ = tr_read<v_rd_off(2, KS, 1)>(vbv), l3_ = tr_read<v_rd_off(3, KS, 0)>(vbv), h3_ = tr_read<v_rd_off(3, KS, 1)>(vbv)
#define PKV(L, H) (bf16x8){L[0], L[1], L[2], L[3], H[0], H[1], H[2], H[3]}
#define PV_MFMA(PA) do { asm volatile("s_waitcnt lgkmcnt(0)" ::: "memory"); SBAR(); \
    o[0] = MFMA32(PKV(l0_, h0_), PA, o[0]); o[1] = MFMA32(PKV(l1_, h1_), PA, o[1]); o[2] = MFMA32(PKV(l2_, h2_), PA, o[2]); o[3] = MFMA32(PKV(l3_, h3_), PA, o[3]); } while (0)
#define ATT_STEP(C0, C1, P0, P1, ALP, ALC, KOFF, KBI, DO_DMA) do { \
    SBAR(); qkt_half<0>(C0, C1, K_lds + (KOFF), qr, Qs, k0, k1, k2, k3, -m_reg); __builtin_amdgcn_sched_barrier(0x7); \
    if (DO_DMA) { DMA(KBI, vwr); VNEXT(vwr); } __builtin_amdgcn_sched_barrier(0x7); \
    qkt_half<1>(C0, C1, K_lds + (KOFF), qr, Qs, k0, k1, k2, k3); \
    finish_part<true>(P0, P1, ALP, l_reg); pa0 = pack8<0>(P0); SBAR(); \
    const int vbv = vb0 + vrd; float pmax_; \
    { PV_READS(0); pa1 = pack8<8>(P0); pmax_ = sm_max(C0, C1); PV_MFMA(pa0); } SBAR(); \
    sm_decide2(pmax_, m_reg, ALC, C0, C1); SBAR(); \
    { PV_READS(1); pa2 = pack8<0>(P1); PV_MFMA(pa1); } SBAR(); \
    { PV_READS(2); pa3 = pack8<8>(P1); PV_MFMA(pa2); } SBAR(); \
    { PV_READS(3); PV_MFMA(pa3); } asm volatile("" : "+v"(C0), "+v"(C1)); SBAR(); \
    VNEXT(vrd); RESC(ALC); } while (0)
  for (int j = 1; j + 1 < NT; j += 2) {
    ATT_STEP(pB0, pB1, pA0, pA1, alA, alB, SHM_K, 0, true); STEP_END();
    ATT_STEP(pA0, pA1, pB0, pB1, alB, alA, 0, 1, true); STEP_END();
  }
  ATT_STEP(pB0, pB1, pA0, pA1, alA, alB, SHM_K, 0, false);
#undef ATT_STEP
  finish_part<true>(pB0, pB1, alB, l_reg); pa0 = pack8<0>(pB0); pa1 = pack8<8>(pB0); pa2 = pack8<0>(pB1); pa3 = pack8<8>(pB1); SBAR();
  { const int vbv = vb0 + vrd;
    { PV_READS(0); PV_MFMA(pa0); } SBAR(); { PV_READS(1); PV_MFMA(pa1); } SBAR(); { PV_READS(2); PV_MFMA(pa2); } SBAR(); { PV_READS(3); PV_MFMA(pa3); } }
#undef PV_MFMA
#undef PKV
#undef PV_READS
  { const float rl = __builtin_amdgcn_rcpf(l_reg);
    u16* Ow = Ob + (long)(wid * 32 + r32) * LDO + 4 * hi;
#pragma unroll
    for (int d0 = 0; d0 < 4; ++d0)
#pragma unroll
      for (int gq = 0; gq < 4; ++gq) {
        u32x2 w; w[0] = cvtpk(o[d0][4 * gq] * rl, o[d0][4 * gq + 1] * rl); w[1] = cvtpk(o[d0][4 * gq + 2] * rl, o[d0][4 * gq + 3] * rl);
        *(u32x2*)(Ow + d0 * 32 + gq * 8) = w; } }
#undef VNEXT
#undef STEP_END
#undef RESC
}

DI void phase_attn(int tid__, int bid__, const u16* Q, const u16* KV, const u16* KRc, u16* O, int c, char* lds) {
  for (int v = bid__; v < 1024; v += gridDim.x) {
    const int x = v & 7, slot = (v >> 3) & 31, rnd = v >> 8;
    int h, tok0, key0, seq;
    if (c < 2) { h = x + 8 * (rnd >> 1); const int qb = slot + 32 * (rnd & 1); tok0 = qb * 256; key0 = 0; seq = 16384; }
    else { const int pr = x + 8 * (2 * rnd + (slot >> 4)); const int b = pr >> 4; h = pr & 15; key0 = b * 4096; tok0 = key0 + (slot & 15) * 256; seq = 4096; }
    attn_tile(tid__, bid__, Q + (long)tok0 * LDQ + h * 192, KV + (long)key0 * LDKV + h * 256, KV + (long)key0 * LDKV + h * 256 + 128, KRc + (long)key0 * 64,
              O + (long)tok0 * LDO + h * 128, seq, lds);
  }
}

DI int v_st64(int k, int c) { const int kk = (k & ~0xC) | ((k & 4) << 1) | ((k & 8) >> 1); return ((kk >> 3) * 2 + (c >> 5)) * 512 + ((kk & 7) * 32 + (c & 31)) * 2; }
constexpr int v_rd_off64(int d0, int ks, int half) { return d0 * 512 + ks * 2048 + half * 1024; }
template <int D0> DI void pv_one64(f32x16& od, int vb, bf16x8 pa0, bf16x8 pa1, bf16x8 pa2, bf16x8 pa3) {
  const s16x4 l0 = tr_read<v_rd_off64(D0, 0, 0)>(vb), h0 = tr_read<v_rd_off64(D0, 0, 1)>(vb), l1 = tr_read<v_rd_off64(D0, 1, 0)>(vb), h1 = tr_read<v_rd_off64(D0, 1, 1)>(vb);
  const s16x4 l2 = tr_read<v_rd_off64(D0, 2, 0)>(vb), h2 = tr_read<v_rd_off64(D0, 2, 1)>(vb), l3 = tr_read<v_rd_off64(D0, 3, 0)>(vb), h3 = tr_read<v_rd_off64(D0, 3, 1)>(vb);
  asm volatile("s_waitcnt lgkmcnt(0)" ::: "memory"); SBAR();
#define PK(L, H) (bf16x8){L[0], L[1], L[2], L[3], H[0], H[1], H[2], H[3]}
  od = MFMA32(pa0, PK(l0, h0), od);
  od = MFMA32(pa1, PK(l1, h1), od);
  od = MFMA32(pa2, PK(l2, h2), od);
  od = MFMA32(pa3, PK(l3, h3), od);
#undef PK
}
DI void phase_na(int tid__, int bid__, const u16* __restrict__ QKV, const float* __restrict__ rpb, u16* __restrict__ O, char* lds) {
  const int tid = tid__, wid = tid >> 6, lane = tid & 63, r32 = lane & 31, hi = lane >> 5;
  const int hp = wid >> 1, m = wid & 1;
  char* K_l = lds; char* V_l = lds + 32768;
  float* rp = (float*)(lds + 131072);
  float* wsf = (float*)(lds + 131072 + 7680) + wid * 64; float* li_l = wsf; float* al_l = wsf + 32;
  const int c = m * 32 + r32, cs = min(max(c - 8, 0), 48);
  const int stok = tid >> 5, cidx = tid & 31, shead = cidx >> 3, sch = cidx & 7;
  const int kst = shead * 8192 + stok * 128 + ((sch ^ ((stok >> 1) & 7)) << 4);
  const int vst = 32768 + shead * 8192 + v_st64(stok, sch * 8);
  const int krd = hp * 8192 + r32 * 128, kx = (r32 >> 1) & 7;
  const int vb = (int)(uintptr_t)V_l + hp * 8192 + v_rd_base(lane);
  for (int v = bid__; v < 3072; v += gridDim.x) {
    const int x = v & 7, rest = v >> 3, g = x * 96 + (rest % 96), hb = (rest / 96) * 4, h = hb + hp;
    int rows, r, seqbase;
    if (g < 512) { rows = 256; r = g & 255; seqbase = (g >> 8) * 16384; } else { rows = 64; r = (g - 512) & 63; seqbase = TP + ((g - 512) >> 6) * 4096; }
    const int r0 = min(max(r - 4, 0), rows - 8);
    const u16* kbase = QKV + (long)(seqbase + r0 * 64 + stok) * 3072 + 1024 + hb * 64 + cidx * 8;
    bf16x8 kr0[4], vr0[4], kr1[4], vr1[4];
#define NA_LOAD(KR, VR, i) do { _Pragma("unroll") for (int it = 0; it < 4; ++it) { const u16* s_ = kbase + (long)((i) * 64 + 16 * it) * 3072; KR[it] = *(const bf16x8*)s_; VR[it] = *(const bf16x8*)(s_ + 1024); } } while (0)
    NA_LOAD(kr0, vr0, 0); NA_LOAD(kr1, vr1, 1);
    bf16x8 qr[4];
    { const u16* qp = QKV + (long)(seqbase + r * 64 + c) * 3072 + h * 64 + hi * 8;
#pragma unroll
      for (int d0 = 0; d0 < 4; ++d0) qr[d0] = *(const bf16x8*)(qp + d0 * 16); }
    __syncthreads();
    for (int i = tid; i < 1860; i += NTHR) rp[i] = rpb[hb * 465 + i];
    float m_reg = -1e30f, l_reg = 0.f; f32x16 o[2];
#pragma unroll
    for (int d = 0; d < 2; ++d)
#pragma unroll
      for (int rr = 0; rr < 16; ++rr) o[d][rr] = 0.f;
#pragma unroll 1
    for (int i2 = 0; i2 < 8; i2 += 2) {
      { const int i = i2, so = 0;
#pragma unroll
        for (int it = 0; it < 4; ++it) { *(bf16x8*)(lds + so + kst + it * 2048) = kr0[it]; *(bf16x8*)(lds + so + vst + it * 2048) = vr0[it]; }
        if (i + 2 < 8) NA_LOAD(kr0, vr0, i + 2);
        __syncthreads();
      f32x16 p0, p1;
#pragma unroll
      for (int rr = 0; rr < 16; ++rr) { p0[rr] = 0.f; p1[rr] = 0.f; }
#pragma unroll
      for (int d0 = 0; d0 < 4; ++d0) {
        const int co = ((d0 * 2 + hi) ^ kx) << 4;
        const bf16x8 b0 = *(const bf16x8*)(K_l + so + krd + co);
        const bf16x8 b1 = *(const bf16x8*)(K_l + so + krd + 4096 + co);
        p0 = MFMA32(b0, qr[d0], p0);
        p1 = MFMA32(b1, qr[d0], p1);
      }
      const float* rph = rp + hp * 465 + (r0 + i - r + 7) * 31 + 15 - c;
      { float bv[16];
#pragma unroll
        for (int rr = 0; rr < 16; ++rr) bv[rr] = rph[crow(rr, hi)];
#pragma unroll
        for (int rr = 0; rr < 16; ++rr) { const float s0 = fmaf(p0[rr], 0.125f, bv[rr]); p0[rr] = ((unsigned)(crow(rr, hi) - cs) < 16u) ? s0 : -1e30f; }
        asm volatile("" : "+v"(p0));
#pragma unroll
        for (int rr = 0; rr < 16; ++rr) bv[rr] = rph[crow(rr, hi) + 32];
#pragma unroll
        for (int rr = 0; rr < 16; ++rr) { const float s1 = fmaf(p1[rr], 0.125f, bv[rr]); p1[rr] = ((unsigned)(crow(rr, hi) + 32 - cs) < 16u) ? s1 : -1e30f; } }
      float mn, al; bf16x8 pa0, pa1, pa2, pa3;
      partialSM<true>(p0, p1, m_reg, mn, al);
      if (__any(al < 1.f)) { if (hi == 0) al_l[r32] = al; asm volatile("s_waitcnt lgkmcnt(0)" ::: "memory");
#pragma unroll
        for (int d = 0; d < 2; ++d)
#pragma unroll
          for (int rr = 0; rr < 16; ++rr) o[d][rr] *= al_l[crow(rr, hi)]; }
      finishSM(p0, p1, al, l_reg, pa0, pa1, pa2, pa3); SBAR();
      pv_one64<0>(o[0], vb + so, pa0, pa1, pa2, pa3); pv_one64<1>(o[1], vb + so, pa0, pa1, pa2, pa3);
      }
      { const int i = i2 + 1, so = 65536;
#pragma unroll
        for (int it = 0; it < 4; ++it) { *(bf16x8*)(lds + so + kst + it * 2048) = kr1[it]; *(bf16x8*)(lds + so + vst + it * 2048) = vr1[it]; }
        if (i + 2 < 8) NA_LOAD(kr1, vr1, i + 2);
        __syncthreads();
      f32x16 p0, p1;
#pragma unroll
      for (int rr = 0; rr < 16; ++rr) { p0[rr] = 0.f; p1[rr] = 0.f; }
#pragma unroll
      for (int d0 = 0; d0 < 4; ++d0) {
        const int co = ((d0 * 2 + hi) ^ kx) << 4;
        const bf16x8 b0 = *(const bf16x8*)(K_l + so + krd + co);
        const bf16x8 b1 = *(const bf16x8*)(K_l + so + krd + 4096 + co);
        p0 = MFMA32(b0, qr[d0], p0);
        p1 = MFMA32(b1, qr[d0], p1);
      }
      const float* rph = rp + hp * 465 + (r0 + i - r + 7) * 31 + 15 - c;
      { float bv[16];
#pragma unroll
        for (int rr = 0; rr < 16; ++rr) bv[rr] = rph[crow(rr, hi)];
#pragma unroll
        for (int rr = 0; rr < 16; ++rr) { const float s0 = fmaf(p0[rr], 0.125f, bv[rr]); p0[rr] = ((unsigned)(crow(rr, hi) - cs) < 16u) ? s0 : -1e30f; }
        asm volatile("" : "+v"(p0));
#pragma unroll
        for (int rr = 0; rr < 16; ++rr) bv[rr] = rph[crow(rr, hi) + 32];
#pragma unroll
        for (int rr = 0; rr < 16; ++rr) { const float s1 = fmaf(p1[rr], 0.125f, bv[rr]); p1[rr] = ((unsigned)(crow(rr, hi) + 32 - cs) < 16u) ? s1 : -1e30f; } }
      float mn, al; bf16x8 pa0, pa1, pa2, pa3;
      partialSM<true>(p0, p1, m_reg, mn, al);
      if (__any(al < 1.f)) { if (hi == 0) al_l[r32] = al; asm volatile("s_waitcnt lgkmcnt(0)" ::: "memory");
#pragma unroll
        for (int d = 0; d < 2; ++d)
#pragma unroll
          for (int rr = 0; rr < 16; ++rr) o[d][rr] *= al_l[crow(rr, hi)]; }
      finishSM(p0, p1, al, l_reg, pa0, pa1, pa2, pa3); SBAR();
      pv_one64<0>(o[0], vb + so, pa0, pa1, pa2, pa3); pv_one64<1>(o[1], vb + so, pa0, pa1, pa2, pa3);
      }
    }
#undef NA_LOAD
    if (hi == 0) li_l[r32] = l_reg; asm volatile("s_waitcnt lgkmcnt(0)" ::: "memory");
    u16* Ow = O + (long)(seqbase + r * 64 + m * 32) * 1024 + h * 64 + r32;
#pragma unroll
    for (int rr = 0; rr < 16; ++rr) { const int q = crow(rr, hi); const float il = __builtin_amdgcn_rcpf(li_l[q]);
      Ow[(long)q * 1024] = (u16)(cvtpk(o[0][rr] * il, 0.f) & 0xffffu); Ow[(long)q * 1024 + 32] = (u16)(cvtpk(o[1][rr] * il, 0.f) & 0xffffu); }
  }
}

#define XB_TMO      128
#define XB_XCNT(j)  (256  + 64 * (j))
#define XB_XSUB(j)  (1280 + 64 * (j))
#define XB_XGEN(j)  (2304 + 64 * (j))
#define XB_TOP      3328
#define XB_TOPGEN   3392
#define XCD_BAR_WORDS 3456
#define XB_SPIN_CAP (1u << 18)
DI unsigned xb_ld(unsigned* p)              { return __hip_atomic_load(p, __ATOMIC_RELAXED, __HIP_MEMORY_SCOPE_AGENT); }
DI unsigned xb_add(unsigned* p, unsigned v) { return __hip_atomic_fetch_add(p, v, __ATOMIC_RELAXED, __HIP_MEMORY_SCOPE_AGENT); }
DI unsigned xb_xcc_id() { return (unsigned)__builtin_amdgcn_s_getreg((3 << 11) | 20) & 0xFu; }
#define XB_SPIN(cond, bar) do { unsigned _sp = 0; while (cond) { __builtin_amdgcn_s_sleep(1); \
    if ((++_sp & 255u) == 0u) { if (xb_ld(&(bar)[XB_TMO])) break; if (_sp > XB_SPIN_CAP) { atomicAdd(&(bar)[XB_TMO], 1u); break; } } } } while (0)
struct XcdBarrier { unsigned* bar; unsigned x; volatile __attribute__((address_space(3))) unsigned* st; };
DI void xcd_barrier_complete(unsigned* bar, unsigned x, unsigned& nloc, unsigned& nx) {
  const unsigned G = gridDim.x * gridDim.y * gridDim.z;
  unsigned sum, cnt, mine, sp = 0u;
  for (;;) {
    sum = 0u; cnt = 0u; mine = 0u;
#pragma unroll
    for (unsigned j = 0; j < 16; ++j) { const unsigned c = xb_ld(&bar[XB_XCNT(j)]); sum += c; cnt += (c > 0u) ? 1u : 0u; mine = (j == x) ? c : mine; }
    if (sum == G) break;
    __builtin_amdgcn_s_sleep(1);
    if ((++sp & 255u) == 0u) { if (xb_ld(&bar[XB_TMO])) break; if (sp > XB_SPIN_CAP) { atomicAdd(&bar[XB_TMO], 1u); break; } }
  }
  nloc = mine > 0u ? mine : 1u; nx = cnt > 0u ? cnt : 1u;
}
DI void xcd_barrier(const XcdBarrier& b, int tid) {
  asm volatile("s_waitcnt vmcnt(0)" ::: "memory");
  __syncthreads();
  if (tid == 0) {
    unsigned* bar = b.bar;
    __builtin_amdgcn_s_waitcnt(0);
    unsigned nloc = b.st[0], nx = b.st[1];
    if (nloc == 0u) { xcd_barrier_complete(bar, b.x, nloc, nx); b.st[0] = nloc; b.st[1] = nx; }
    const unsigned old = xb_add(&bar[XB_XSUB(b.x)], 1u);
    const unsigned gen = old / nloc;
    if (old + 1u == (gen + 1u) * nloc) {
      __builtin_amdgcn_fence(__ATOMIC_RELEASE, "agent");
      asm volatile("s_waitcnt vmcnt(0)" ::: "memory");
      const unsigned og = xb_add(&bar[XB_TOP], 1u);
      const unsigned tg = og / nx;
      if (og + 1u == (tg + 1u) * nx) xb_add(&bar[XB_TOPGEN], 1u);
      else XB_SPIN(xb_ld(&bar[XB_TOPGEN]) == tg, bar);
      __builtin_amdgcn_fence(__ATOMIC_ACQUIRE, "agent");
      xb_add(&bar[XB_XGEN(b.x)], 1u);
      asm volatile("s_waitcnt vmcnt(0)" ::: "memory");
    } else {
      XB_SPIN(xb_ld(&bar[XB_XGEN(b.x)]) == gen, bar);
      __builtin_amdgcn_fence(__ATOMIC_ACQUIRE, "agent");
      asm volatile("s_waitcnt vmcnt(0)" ::: "memory");
    }
  }
  __syncthreads();
}

struct EpiArgs { u16* C16; int ldc; float* Cf; const float* R; const float2* rope; int row0; };
enum { K_PRO = 0, K_RMS, K_LAT, K_G_BF16, K_G_QROPE, K_G_RELU2, K_G_RESID, K_G_RESID_ST, K_ATTN, K_NA, K_FINAL };
constexpr int NSTEPS = 32;
__global__ void __launch_bounds__(NTHR) fwd_megakernel(Params p) {
  __shared__ __attribute__((aligned(16))) char lds[LDS_BYTES];
  cg::grid_group grid = cg::this_grid();
#ifdef PROBE_REP_KIND
  int repeated = 0;
#endif
  const int wave_s__ = __builtin_amdgcn_readfirstlane((int)__builtin_amdgcn_workitem_id_x() >> 6);
  XcdBarrier xbar; xbar.bar = (unsigned*)(p.ws + WS_BAR); xbar.x = xb_xcc_id(); xbar.st = (volatile __attribute__((address_space(3))) unsigned*)(lds + LDS_BYTES - 16);
  if (__builtin_amdgcn_workitem_id_x() == 0) { xbar.st[0] = 0u; xbar.st[1] = 0u; (void)xb_add(&xbar.bar[XB_XCNT(xbar.x)], 1u); }
  __syncthreads();
#pragma unroll 1
  for (int ph = 0; ph < NSTEPS; ++ph) {
    int lane__, bid__ = __builtin_amdgcn_workgroup_id_x();
    asm volatile("v_mbcnt_lo_u32_b32 %0, -1, 0\n\tv_mbcnt_hi_u32_b32 %0, -1, %0" : "=v"(lane__));
    int tid__ = wave_s__ * 64 + lane__;
    asm volatile("" : "+v"(tid__), "+s"(bid__));
    char* ws = p.ws;
    int kind = K_FINAL, sync = 1, chunk = 0;
    const u16* gA = nullptr; const u16* gB = nullptr; int lda = 0, gK = 0, gM = 0, gN = 0;
    EpiArgs ea{nullptr, 0, nullptr, nullptr, nullptr, 0};
    u16* eXB = nullptr; float* eSS = (float*)(ws + WS_SS);
    if (ph == 0) { kind = K_PRO; }
    else if (ph == 1) { kind = K_G_BF16; gA = (const u16*)(ws + WS_A); lda = DM; gB = (const u16*)(ws + W_DQKV); gK = 1024; gM = TT; gN = 768; ea.C16 = (u16*)(ws + WS_B); ea.ldc = 768; }
    else if (ph == 2) { kind = K_LAT; }
    else if (ph < 21) {
      const int c = (ph - 3) / 6, sub = (ph - 3) - 6 * c; chunk = c;
      if (sub == 0) { kind = K_G_QROPE; sync = 0; gA = (const u16*)(ws + WS_CQ) + (long)c * CH * 384; lda = 384; gB = (const u16*)(ws + W_UQ); gK = 384; gM = CH; gN = 3072;
                      ea.C16 = (u16*)(ws + WS_A); ea.ldc = 3072; ea.rope = (const float2*)(ws + WS_ROPE); ea.row0 = c * CH; }
      else if (sub == 1) { kind = K_G_BF16; gA = (const u16*)(ws + WS_CKV) + (long)c * CH * 256; lda = 256; gB = (const u16*)(ws + W_UKV); gK = 256; gM = CH; gN = 4096;
                           ea.C16 = (u16*)(ws + WS_D); ea.ldc = 4096; }
      else if (sub == 2) { kind = K_ATTN; }
      else if (sub == 3) { kind = K_G_RESID_ST; gA = (const u16*)(ws + WS_B); lda = 2048; gB = (const u16*)(ws + W_O); gK = 2048; gM = CH; gN = DM;
             ea.ldc = DM; ea.Cf = p.out + (long)c * CH * DM; ea.R = c < 2 ? p.xp + (long)c * CH * DM : p.xs;
             eXB = (u16*)(ws + WS_A); eSS += (long)c * CH; }
      else if (sub == 4) { kind = K_G_RELU2; gA = (const u16*)(ws + WS_A); lda = DM; gB = (const u16*)(ws + W_W1); gK = 1024; gM = CH; gN = 4096;
                           ea.C16 = (u16*)(ws + WS_D); ea.ldc = 4096; eSS += (long)c * CH; }
      else { kind = K_G_RESID; gA = (const u16*)(ws + WS_D); lda = 4096; gB = (const u16*)(ws + W_W2); gK = 4096; gM = CH; gN = DM;
             ea.ldc = DM; ea.Cf = p.out + (long)c * CH * DM; ea.R = ea.Cf; }
    }
    else if (ph == 21) { kind = K_RMS; }
    else if (ph == 22) { kind = K_G_BF16; gA = (const u16*)(ws + WS_H1); lda = DM; gB = (const u16*)(ws + W_NAQKV); gK = 1024; gM = TT; gN = 3072; ea.C16 = (u16*)(ws + WS_NAQKV); ea.ldc = 3072; }
    else if (ph == 23) { kind = K_NA; }
    else if (ph == 24) { kind = K_G_RESID_ST; gA = (const u16*)(ws + WS_H1); lda = DM; gB = (const u16*)(ws + W_NAO); gK = 1024; gM = TT; gN = DM; ea.ldc = DM; ea.Cf = p.out; ea.R = p.out;
                         eXB = (u16*)(ws + WS_A); }
    else if (ph < 31) {
      const int q = ph - 25, c = q >> 1;
      if ((q & 1) == 0) { kind = K_G_RELU2; gA = (const u16*)(ws + WS_A) + (long)c * CH * DM; lda = DM; gB = (const u16*)(ws + W_W1) + (long)4096 * 1024; gK = 1024; gM = CH; gN = 4096;
                          ea.C16 = (u16*)(ws + WS_D); ea.ldc = 4096; eSS += (long)c * CH; }
      else { kind = K_G_RESID; gA = (const u16*)(ws + WS_D); lda = 4096; gB = (const u16*)(ws + W_W2) + (long)4096 * 1024; gK = 4096; gM = CH; gN = DM;
             ea.ldc = DM; ea.Cf = p.out + (long)c * CH * DM; ea.R = ea.Cf; }
    }
    else { kind = K_FINAL; sync = 0; }

    switch (kind) {
      case K_PRO:
        phase_prologue(tid__, bid__, p, lds);
        phase_rmsnorm_bf16(tid__, bid__, p.xp, p.xs, TP, p.attn_norm, (u16*)(ws + WS_A));
        break;
      case K_RMS: phase_rmsnorm_bf16(tid__, bid__, p.out, p.out, TT, p.attn_norm + DM, (u16*)(ws + WS_H1), (float*)(ws + WS_SS)); break;
      case K_LAT: phase_lat_norm(tid__, bid__, (const u16*)(ws + WS_B), p.q_norm, p.kv_norm, (const float2*)(ws + WS_ROPE), (u16*)(ws + WS_CQ), (u16*)(ws + WS_CKV), (u16*)(ws + WS_KR)); break;
      case K_G_BF16: { pg8::Gemm g{gA, gB, gM, gN, gK}; pg8::StaticOrder S; S.init(gM, gN, (int)gridDim.x, bid__); pg8::EpiBf16<0> E{ea.C16, ea.ldc, nullptr};
        pg8::gemm_phase(tid__, (PG8_LAS unsigned char*)lds, g, S, E); } break;
      case K_G_QROPE: { pg8::Gemm g{gA, gB, gM, gN, gK}; pg8::StaticOrder S; S.init(gM, gN, (int)gridDim.x, bid__); pg8::EpiQRope E{ea.C16, ea.ldc, (const float*)ea.rope, ea.row0, ATT_SCALE * 1.4426950408889634f};
        pg8::gemm_phase(tid__, (PG8_LAS unsigned char*)lds, g, S, E); } break;
      case K_G_RELU2: { pg8::Gemm g{gA, gB, gM, gN, gK}; pg8::StaticOrder S; S.init(gM, gN, (int)gridDim.x, bid__); pg8::EpiBf16<1> E{ea.C16, ea.ldc, eSS};
        pg8::gemm_phase(tid__, (PG8_LAS unsigned char*)lds, g, S, E); } break;
      case K_G_RESID: { pg8::Gemm g{gA, gB, gM, gN, gK}; pg8::StaticOrder S; S.init(gM, gN, (int)gridDim.x, bid__); pg8::EpiResid<false> E{ea.Cf, ea.R, ea.ldc, nullptr, nullptr};
        pg8::gemm_phase(tid__, (PG8_LAS unsigned char*)lds, g, S, E); } break;
      case K_G_RESID_ST: { pg8::Gemm g{gA, gB, gM, gN, gK}; pg8::StaticOrder S; S.init(gM, gN, (int)gridDim.x, bid__); pg8::EpiResid<true> E{ea.Cf, ea.R, ea.ldc, eXB, eSS};
        pg8::gemm_phase(tid__, (PG8_LAS unsigned char*)lds, g, S, E); } break;
      case K_ATTN:
        phase_attn(tid__, bid__, (const u16*)(ws + WS_A), (const u16*)(ws + WS_D), (const u16*)(ws + WS_KR) + (long)chunk * CH * 64, (u16*)(ws + WS_B), chunk, lds); break;
      case K_NA:
        phase_na(tid__, bid__, (const u16*)(ws + WS_NAQKV), p.na_rpb, (u16*)(ws + WS_H1), lds); break;
      default: phase_rmsnorm_final(tid__, bid__, p.out, p.final_norm); break;
    }
    if (sync) { if (gridDim.x == 0u) grid.sync();   xcd_barrier(xbar, tid__); }
#ifdef PROBE_REP_KIND
    if (kind == PROBE_REP_KIND && !repeated) { repeated = 1; --ph; } else repeated = 0;
#endif
  }
}

extern "C" void kernel_launch(void* const* d_in, const int* in_sizes, int n_in, void* d_out, int out_size, void* d_ws, size_t ws_size, hipStream_t stream) {
  static int grid_blocks = 0;
  if (!grid_blocks) {
    int dev = 0, cus = 0, per_cu = 0;
    hipGetDevice(&dev);
    hipDeviceGetAttribute(&cus, hipDeviceAttributeMultiprocessorCount, dev);
    hipOccupancyMaxActiveBlocksPerMultiprocessor(&per_cu, fwd_megakernel, NTHR, 0);
    if (per_cu != 1) per_cu = 1;
    grid_blocks = cus * per_cu;
    if (ws_size < WS_END) fprintf(stderr, "kernel_launch: workspace too small: %zu < %zu\n", ws_size, (size_t)WS_END);
  }
  Params p{};
  p.xp = (const float*)d_in[0]; p.xs = (const float*)d_in[1]; p.attn_norm = (const float*)d_in[2]; p.mlp_norm = (const float*)d_in[3];
  p.final_norm = (const float*)d_in[4]; p.w_dq = (const float*)d_in[5]; p.q_norm = (const float*)d_in[6]; p.w_uq = (const float*)d_in[7];
  p.w_dkv = (const float*)d_in[8]; p.kv_norm = (const float*)d_in[9]; p.w_ukv = (const float*)d_in[10]; p.w_o = (const float*)d_in[11];
  p.na_w_qkv = (const float*)d_in[12]; p.na_rpb = (const float*)d_in[13]; p.na_w_o = (const float*)d_in[14]; p.w1 = (const float*)d_in[15];
  p.w2 = (const float*)d_in[16]; p.out = (float*)d_out; p.ws = (char*)d_ws;
  (void)hipMemsetAsync((char*)d_ws + WS_BAR, 0, XCD_BAR_WORDS * 4, stream);
  void* args[] = {&p};
  hipError_t e = hipLaunchCooperativeKernel((void*)fwd_megakernel, dim3(grid_blocks), dim3(NTHR), args, 0, stream);
  if (e != hipSuccess) fprintf(stderr, "cooperative launch failed: %s (grid %d)\n", hipGetErrorString(e), grid_blocks);
}
```

```cpp
#include <hip/hip_runtime.h>
#include <hip/hip_cooperative_groups.h>
#include <cstdio>
#include <cstdint>
namespace cg = cooperative_groups;

typedef unsigned short u16;
using bf16x8 = __attribute__((ext_vector_type(8))) short;
using s16x4  = __attribute__((ext_vector_type(4))) short;
using f32x16 = __attribute__((ext_vector_type(16))) float;
using f32x4  = __attribute__((ext_vector_type(4))) float;
using u32x4  = __attribute__((ext_vector_type(4))) unsigned;
using u32x2  = __attribute__((ext_vector_type(2))) unsigned;
#define DI __device__ __forceinline__
#define SBAR() __builtin_amdgcn_sched_barrier(0)
#define MFMA32(a, b, c) __builtin_amdgcn_mfma_f32_32x32x16_bf16((a), (b), (c), 0, 0, 0)

constexpr int DM = 1024, TP = 32768, TS = 16384, TT = 49152, CH = 16384;
constexpr int NTHR = 512;
constexpr float EPS = 1e-6f;
constexpr size_t MiB = 1048576;
constexpr size_t W_DQKV = 0, W_UQ = 1572864, W_UKV = 3932160, W_O = 6029312, W_NAQKV = 10223616, W_NAO = 16515072, W_W1 = 18612224, W_W2 = 35389440;
constexpr size_t WS_ROPE = 50 * MiB, WS_A = 54 * MiB, WS_B = 150 * MiB, WS_CQ = 222 * MiB, WS_CKV = 258 * MiB, WS_KR = 282 * MiB, WS_D = 288 * MiB;
constexpr size_t WS_NAQKV = 54 * MiB, WS_H1 = 342 * MiB, WS_BAR = 52166656, WS_SS = 52166656 + 16384, WS_END = 438 * MiB;
constexpr int LDS_BYTES = 147456;

__device__ const double c_inv[32] = {1.0, 0.7498942093324559, 0.5623413251903491, 0.4216965034285822, 0.31622776601683794, 0.23713737056616552, 0.1778279410038923, 0.1333521432163324, 0.1, 0.07498942093324558, 0.05623413251903491, 0.042169650342858224, 0.03162277660168379, 0.023713737056616554, 0.01778279410038923, 0.01333521432163324, 0.01, 0.007498942093324558, 0.005623413251903491, 0.004216965034285823, 0.0031622776601683794, 0.0023713737056616554, 0.0017782794100389228, 0.001333521432163324, 0.001, 0.0007498942093324559, 0.0005623413251903491, 0.00042169650342858224, 0.00031622776601683794, 0.00023713737056616554, 0.00017782794100389227, 0.0001333521432163324};

struct Params {
  const float *xp, *xs, *attn_norm, *mlp_norm, *final_norm, *w_dq, *q_norm, *w_uq, *w_dkv, *kv_norm, *w_ukv, *w_o, *na_w_qkv, *na_rpb, *na_w_o, *w1, *w2;
  float* out; char* ws;
};

DI unsigned cvtpk(float lo, float hi) { unsigned r; asm volatile("v_cvt_pk_bf16_f32 %0, %1, %2" : "=v"(r) : "v"(lo), "v"(hi)); return r; }
DI float bflo(unsigned w) { return __uint_as_float(w << 16); }
DI float bfhi(unsigned w) { return __uint_as_float(w & 0xffff0000u); }
DI int crow(int r, int hi) { return (r & 3) + 8 * (r >> 2) + 4 * hi; }
DI int tok_pos(int g) { return g < TP ? (g & 16383) : ((g - TP) & 4095); }
#define SWZ_XOR(v, k) __int_as_float(__builtin_amdgcn_ds_swizzle(__float_as_int(v), ((k) << 10) | 0x1f))
DI float wave_sum(float v) {
  v += SWZ_XOR(v, 1); v += SWZ_XOR(v, 2); v += SWZ_XOR(v, 4); v += SWZ_XOR(v, 8); v += SWZ_XOR(v, 16);
  auto rr = __builtin_amdgcn_permlane32_swap(__float_as_uint(v), __float_as_uint(v), false, false);
  return __uint_as_float(rr[0]) + __uint_as_float(rr[1]);
}

template <bool QPERM = false>
DI void convert_matrix(int tid__, int bid__, const float* __restrict__ W, u16* __restrict__ Wt, int K, int N, char* lds, const float* __restrict__ gain = nullptr) {
  float* tile = (float*)lds;
  const int tid = tid__;
  const int tn = N >> 6, nt = tn * (K >> 6);
  for (int t = bid__; t < nt; t += gridDim.x) {
    const int k0 = (t / tn) << 6, n0 = (t % tn) << 6;
    const int lr = tid >> 4, lc = (tid & 15) << 2;
#pragma unroll
    for (int i = 0; i < 2; ++i) {
      f32x4 v = *(const f32x4*)(W + (long)(k0 + lr + 32 * i) * N + n0 + lc);
      if (gain) { const float gk = gain[k0 + lr + 32 * i]; v[0] *= gk; v[1] *= gk; v[2] *= gk; v[3] *= gk; }
      float* d = tile + (lr + 32 * i) * 65 + lc;
      d[0] = v[0]; d[1] = v[1]; d[2] = v[2]; d[3] = v[3];
    }
    __syncthreads();
    const int n = tid >> 3, kc = (tid & 7) << 3;
    const float* s = tile + kc * 65 + n;
    u32x4 o;
    o[0] = cvtpk(s[0], s[65]); o[1] = cvtpk(s[130], s[195]); o[2] = cvtpk(s[260], s[325]); o[3] = cvtpk(s[390], s[455]);
    int nd = n0 + n;
    if (QPERM) { const int hc = nd % 192; if (hc >= 128) { const int e = hc - 128; nd = nd - hc + 128 + 2 * (e & 31) + (e >> 5); } }
    *(u32x4*)(Wt + (long)nd * K + k0 + kc) = o;
    __syncthreads();
  }
}

DI void phase_prologue(int tid__, int bid__, const Params& p, char* lds) {
  char* ws = p.ws;
  convert_matrix(tid__, bid__, p.w_dq, (u16*)(ws + W_DQKV), 1024, 384, lds);
  convert_matrix(tid__, bid__, p.w_dkv, (u16*)(ws + W_DQKV) + 384 * 1024, 1024, 320, lds);
  convert_matrix<true>(tid__, bid__, p.w_uq, (u16*)(ws + W_UQ), 384, 3072, lds);
  convert_matrix(tid__, bid__, p.w_ukv, (u16*)(ws + W_UKV), 256, 4096, lds);
  convert_matrix(tid__, bid__, p.w_o, (u16*)(ws + W_O), 2048, 1024, lds);
  convert_matrix(tid__, bid__, p.na_w_qkv, (u16*)(ws + W_NAQKV), 1024, 3072, lds);
  convert_matrix(tid__, bid__, p.na_w_o, (u16*)(ws + W_NAO), 1024, 1024, lds);
  convert_matrix(tid__, bid__, p.w1, (u16*)(ws + W_W1), 1024, 4096, lds, p.mlp_norm);
  convert_matrix(tid__, bid__, p.w1 + 1024 * 4096, (u16*)(ws + W_W1) + 4096 * 1024, 1024, 4096, lds, p.mlp_norm + DM);
  convert_matrix(tid__, bid__, p.w2, (u16*)(ws + W_W2), 4096, 1024, lds);
  convert_matrix(tid__, bid__, p.w2 + 1024 * 4096, (u16*)(ws + W_W2) + 4096 * 1024, 4096, 1024, lds);
  const int gt = bid__ * NTHR + tid__, gs = gridDim.x * NTHR;
  for (int i = gt; i < 8192; i += gs) ((u32x4*)((u16*)(ws + W_DQKV) + 704 * 1024))[i] = (u32x4){0u, 0u, 0u, 0u};
  for (int i = gt; i < TT; i += gs) ((float*)(ws + WS_SS))[i] = 0.f;
  float2* rope = (float2*)(ws + WS_ROPE);
  for (int i = gt; i < 16384 * 32; i += gs) {
    const int pos = i >> 5, k = i & 31;
    const double rev = (double)pos * c_inv[k] * 0.15915494309189535;
    const float f = (float)(rev - floor(rev));
    rope[i] = make_float2(__builtin_amdgcn_cosf(f), __builtin_amdgcn_sinf(f));
  }
}

DI void phase_rmsnorm_bf16(int tid__, int bid__, const float* src0, const float* src1, int split, const float* __restrict__ g, u16* __restrict__ H, float* zero_ss = nullptr) {
  const int wid = tid__ >> 6, lane = tid__ & 63;
  if (zero_ss) for (int i = bid__ * NTHR + tid__; i < TT; i += gridDim.x * NTHR) zero_ss[i] = 0.f;
  f32x4 gv[4];
#pragma unroll
  for (int i = 0; i < 4; ++i) gv[i] = *(const f32x4*)(g + lane * 4 + 256 * i);
  for (int row = (bid__ * 8 + wid) * 2; row < TT; row += gridDim.x * 16) {
    const float* x = row < split ? src0 + (long)row * DM : src1 + (long)(row - split) * DM;
    f32x4 v[4], w[4]; float ss = 0.f, st = 0.f;
#pragma unroll
    for (int i = 0; i < 4; ++i) { v[i] = *(const f32x4*)(x + lane * 4 + 256 * i); w[i] = *(const f32x4*)(x + DM + lane * 4 + 256 * i); }
#pragma unroll
    for (int i = 0; i < 4; ++i) { ss += v[i][0] * v[i][0] + v[i][1] * v[i][1] + v[i][2] * v[i][2] + v[i][3] * v[i][3]; st += w[i][0] * w[i][0] + w[i][1] * w[i][1] + w[i][2] * w[i][2] + w[i][3] * w[i][3]; }
    ss = wave_sum(ss); st = wave_sum(st);
    const float rs = rsqrtf(ss * (1.f / DM) + EPS), rt = rsqrtf(st * (1.f / DM) + EPS);
#pragma unroll
    for (int i = 0; i < 4; ++i) {
      u32x2 o; o[0] = cvtpk(v[i][0] * rs * gv[i][0], v[i][1] * rs * gv[i][1]); o[1] = cvtpk(v[i][2] * rs * gv[i][2], v[i][3] * rs * gv[i][3]);
      *(u32x2*)(H + (long)row * DM + lane * 4 + 256 * i) = o;
      u32x2 q; q[0] = cvtpk(w[i][0] * rt * gv[i][0], w[i][1] * rt * gv[i][1]); q[1] = cvtpk(w[i][2] * rt * gv[i][2], w[i][3] * rt * gv[i][3]);
      *(u32x2*)(H + (long)(row + 1) * DM + lane * 4 + 256 * i) = q;
    }
  }
}
DI void phase_rmsnorm_final(int tid__, int bid__, float* x, const float* __restrict__ g) {
  const int wid = tid__ >> 6, lane = tid__ & 63;
  f32x4 gv[4];
#pragma unroll
  for (int i = 0; i < 4; ++i) gv[i] = *(const f32x4*)(g + lane * 4 + 256 * i);
  for (int row = (bid__ * 8 + wid) * 2; row < TT; row += gridDim.x * 16) {
    float* xr = x + (long)row * DM;
    f32x4 v[4], w[4]; float ss = 0.f, st = 0.f;
#pragma unroll
    for (int i = 0; i < 4; ++i) { v[i] = *(const f32x4*)(xr + lane * 4 + 256 * i); w[i] = *(const f32x4*)(xr + DM + lane * 4 + 256 * i); }
#pragma unroll
    for (int i = 0; i < 4; ++i) { ss += v[i][0] * v[i][0] + v[i][1] * v[i][1] + v[i][2] * v[i][2] + v[i][3] * v[i][3]; st += w[i][0] * w[i][0] + w[i][1] * w[i][1] + w[i][2] * w[i][2] + w[i][3] * w[i][3]; }
    ss = wave_sum(ss); st = wave_sum(st);
    const float rs = rsqrtf(ss * (1.f / DM) + EPS), rt = rsqrtf(st * (1.f / DM) + EPS);
#pragma unroll
    for (int i = 0; i < 4; ++i) {
      f32x4 o; o[0] = v[i][0] * rs * gv[i][0]; o[1] = v[i][1] * rs * gv[i][1]; o[2] = v[i][2] * rs * gv[i][2]; o[3] = v[i][3] * rs * gv[i][3];
      *(f32x4*)(xr + lane * 4 + 256 * i) = o;
      f32x4 q; q[0] = w[i][0] * rt * gv[i][0]; q[1] = w[i][1] * rt * gv[i][1]; q[2] = w[i][2] * rt * gv[i][2]; q[3] = w[i][3] * rt * gv[i][3];
      *(f32x4*)(xr + DM + lane * 4 + 256 * i) = q;
    }
  }
}
DI void phase_lat_norm(int tid__, int bid__, const u16* __restrict__ CQKV, const float* __restrict__ qn, const float* __restrict__ kvn, const float2* __restrict__ rope,
                               u16* __restrict__ CQ, u16* __restrict__ CKV, u16* __restrict__ KR) {
  const int wid = tid__ >> 6, lane = tid__ & 63;
  constexpr int NR = 4;
  float gq[6], gk[4];
#pragma unroll
  for (int i = 0; i < 3; ++i) { gq[2 * i] = qn[lane * 2 + 128 * i]; gq[2 * i + 1] = qn[lane * 2 + 128 * i + 1]; }
#pragma unroll
  for (int i = 0; i < 2; ++i) { gk[2 * i] = kvn[lane * 2 + 128 * i]; gk[2 * i + 1] = kvn[lane * 2 + 128 * i + 1]; }
  for (int row0 = (bid__ * 8 + wid) * NR; row0 < TT; row0 += gridDim.x * 8 * NR) {
    unsigned q[NR][3], c[NR][2]; unsigned kru[NR]; float2 cs[NR];
#pragma unroll
    for (int r = 0; r < NR; ++r) {
      const u16* x = CQKV + (long)(row0 + r) * 768;
#pragma unroll
      for (int i = 0; i < 3; ++i) q[r][i] = *(const unsigned*)(x + lane * 2 + 128 * i);
#pragma unroll
      for (int i = 0; i < 2; ++i) c[r][i] = *(const unsigned*)(x + 384 + lane * 2 + 128 * i);
      kru[r] = x[640 + lane];
      cs[r] = rope[tok_pos(row0 + r) * 32 + (lane & 31)];
    }
#pragma unroll
    for (int r = 0; r < NR; ++r) {
      const int row = row0 + r;
      float sq = 0.f, sc = 0.f;
#pragma unroll
      for (int i = 0; i < 3; ++i) { const float a = bflo(q[r][i]), b = bfhi(q[r][i]); sq += a * a + b * b; }
#pragma unroll
      for (int i = 0; i < 2; ++i) { const float a = bflo(c[r][i]), b = bfhi(c[r][i]); sc += a * a + b * b; }
      const float kr = __uint_as_float(kru[r] << 16);
      sq = wave_sum(sq); sc = wave_sum(sc);
      const float rq = rsqrtf(sq * (1.f / 384.f) + EPS), rc = rsqrtf(sc * (1.f / 256.f) + EPS);
#pragma unroll
      for (int i = 0; i < 3; ++i) { const int e = lane * 2 + 128 * i; *(unsigned*)(CQ + (long)row * 384 + e) = cvtpk(bflo(q[r][i]) * rq * gq[2 * i], bfhi(q[r][i]) * rq * gq[2 * i + 1]); }
#pragma unroll
      for (int i = 0; i < 2; ++i) { const int e = lane * 2 + 128 * i; *(unsigned*)(CKV + (long)row * 256 + e) = cvtpk(bflo(c[r][i]) * rc * gk[2 * i], bfhi(c[r][i]) * rc * gk[2 * i + 1]); }
      float other;
      { auto rr = __builtin_amdgcn_permlane32_swap(__float_as_uint(kr), __float_as_uint(kr), false, false); other = __uint_as_float(lane < 32 ? rr[1] : rr[0]); }
      const float o = lane < 32 ? kr * cs[r].x - other * cs[r].y : other * cs[r].y + kr * cs[r].x;
      KR[(long)row * 64 + 2 * (lane & 31) + (lane >> 5)] = (u16)(cvtpk(o, 0.f) & 0xffffu);
    }
  }
}

namespace pg8 {
#define PG8_LAS __attribute__((address_space(3)))
typedef unsigned short bf16_t;
typedef short bf16x8 __attribute__((ext_vector_type(8)));
typedef float f32x4 __attribute__((ext_vector_type(4)));
typedef unsigned u32x4 __attribute__((ext_vector_type(4)));
constexpr int BM = 256, BK = 64, HALF = 128, HTB = HALF * BK * 2  , STAGE_BYTES = 8 * HTB, NXCD = 8, WGM = 8;

__host__ __device__ __forceinline__ int lds_byte(int r, int c) { const int st = (r >> 4) * 2 + (c >> 5), rr = r & 15, cc = c & 31, ob = rr * 64 + cc * 2; return st * 1024 + (ob ^ (((ob >> 9) & 1) << 5)); }
__host__ __device__ __forceinline__ void stage_rc(int b, int& R, int& C) { const int st = b / 1024, sb = b % 1024, swz = sb ^ (((sb >> 9) & 1) << 5); R = (st >> 1) * 16 + swz / 64; C = (st & 1) * 32 + (swz % 64) / 2; }
__host__ __device__ __forceinline__ int perm32(int rho) { const int n = rho >> 4, i = rho & 15; return 8 * (i >> 2) + 4 * n + (i & 3); }

struct Unit { int pm, pn; };
struct Gemm { const bf16_t* A; const bf16_t* Bt; int M, N, K; };

struct StaticOrder {
    int nM, nN, nwg, G, c;
    __host__ __device__ void init(int M, int N, int G_, int c_) { nM = M / BM; nN = N / BM; nwg = nM * nN; G = G_; c = c_; }
    __host__ __device__ bool next(int i, Unit& u) const {
        const long L = (long)i * G + c; if (L >= nwg) return false;
        int wgid = (int)L; { const int q = nwg / NXCD, r = nwg % NXCD, xcd = wgid % NXCD, off = wgid / NXCD; wgid = (xcd < r ? xcd * (q + 1) : r * (q + 1) + (xcd - r) * q) + off; }
        const int nig = WGM * nN, gid = wgid / nig, fm = gid * WGM, gsz = (nM - fm) < WGM ? (nM - fm) : WGM;
        u.pm = fm + ((wgid % nig) % gsz); u.pn = (wgid % nig) / gsz; return true;
    }
    __device__ __forceinline__ void a_ready(const Unit&) const {}
    __device__ __forceinline__ void done(const Unit&) const {}
};

__device__ __forceinline__ unsigned cvt_pk_bf16(float lo, float hi) { unsigned r; asm volatile("v_cvt_pk_bf16_f32 %0, %1, %2" : "=v"(r) : "v"(lo), "v"(hi)); return r; }
__device__ __forceinline__ unsigned long long wall_clock64_() { return 0ull; }
template <int ACT> struct EpiBf16 {
    static constexpr bool PERM = true, AFTER_DRAIN = false;
    bf16_t* O; int ldc; const float* ss;
    __device__ __forceinline__ void operator()(const f32x4 (&acc)[2][2][4][2], const Unit& u, int wr, int wc, int fr, int fq) const {
        const int row0 = u.pm * BM + wr * 64 + fr, col0 = u.pn * BM + wc * 32 + 8 * fq;
#pragma unroll
        for (int ai = 0; ai < 2; ++ai)
#pragma unroll
            for (int m = 0; m < 4; ++m) { bf16_t* rowp = O + (size_t)(row0 + ai * HALF + m * 16) * ldc + col0;
                float rs2 = 1.f; if (ACT == 1) rs2 = __builtin_amdgcn_rcpf(ss[row0 + ai * HALF + m * 16] * (1.f / 1024.f) + 1e-6f);
#pragma unroll
                for (int bj = 0; bj < 2; ++bj) { f32x4 v0 = acc[ai][bj][m][0], v1 = acc[ai][bj][m][1];
                    if (ACT == 1) {
#pragma unroll
                        for (int j = 0; j < 4; ++j) { const float a = fmaxf(v0[j], 0.f), b = fmaxf(v1[j], 0.f); v0[j] = a * a * rs2; v1[j] = b * b * rs2; } }
                    u32x4 w; w.x = cvt_pk_bf16(v0[0], v0[1]); w.y = cvt_pk_bf16(v0[2], v0[3]); w.z = cvt_pk_bf16(v1[0], v1[1]); w.w = cvt_pk_bf16(v1[2], v1[3]);
                    *(u32x4*)(rowp + bj * HALF) = w; } }
    }
};
struct EpiQRope {
    static constexpr bool PERM = true, AFTER_DRAIN = false;
    bf16_t* O; int ldc; const float* rope; int grow0; float qs;
    __device__ __forceinline__ void operator()(const f32x4 (&acc)[2][2][4][2], const Unit& u, int wr, int wc, int fr, int fq) const {
        const int row0 = u.pm * BM + wr * 64 + fr, colw = u.pn * BM + wc * 32, col0 = colw + 8 * fq;
#pragma unroll
        for (int ai = 0; ai < 2; ++ai)
#pragma unroll
            for (int m = 0; m < 4; ++m) { const int row = row0 + ai * HALF + m * 16; bf16_t* rowp = O + (size_t)row * ldc + col0;
                const int g = grow0 + row, pos = g < 32768 ? (g & 16383) : ((g - 32768) & 4095);
#pragma unroll
                for (int bj = 0; bj < 2; ++bj) { f32x4 v0 = acc[ai][bj][m][0], v1 = acc[ai][bj][m][1];
                    const int hcw = (colw + bj * HALF) % 192;
                    if (hcw >= 128) {
                        const float* rp = rope + ((size_t)pos * 32 + ((hcw - 128) >> 1) + 4 * fq) * 2;
                        const f32x4 c0 = *(const f32x4*)rp, c1 = *(const f32x4*)(rp + 4);
                        f32x4 r0, r1;
                        r0[0] = v0[0] * c0[0] - v0[1] * c0[1]; r0[1] = v0[0] * c0[1] + v0[1] * c0[0];
                        r0[2] = v0[2] * c0[2] - v0[3] * c0[3]; r0[3] = v0[2] * c0[3] + v0[3] * c0[2];
                        r1[0] = v1[0] * c1[0] - v1[1] * c1[1]; r1[1] = v1[0] * c1[1] + v1[1] * c1[0];
                        r1[2] = v1[2] * c1[2] - v1[3] * c1[3]; r1[3] = v1[2] * c1[3] + v1[3] * c1[2];
                        v0 = r0; v1 = r1;
                    }
                    v0 *= qs; v1 *= qs;
                    u32x4 w; w.x = cvt_pk_bf16(v0[0], v0[1]); w.y = cvt_pk_bf16(v0[2], v0[3]); w.z = cvt_pk_bf16(v1[0], v1[1]); w.w = cvt_pk_bf16(v1[2], v1[3]);
                    *(u32x4*)(rowp + bj * HALF) = w; } }
    }
};
template <bool STATS> struct EpiResid {
    static constexpr bool PERM = false, AFTER_DRAIN = false;
    float* C; const float* R; int ldc; bf16_t* XB; float* ss;
    __device__ __forceinline__ void operator()(const f32x4 (&acc)[2][2][4][2], const Unit& u, int wr, int wc, int fr, int fq) const {
        const int row0 = u.pm * BM + wr * 64 + fr, col0 = u.pn * BM + wc * 32 + 4 * fq;
#pragma unroll
        for (int ai = 0; ai < 2; ++ai)
#pragma unroll
            for (int m = 0; m < 4; ++m) { const int row = row0 + ai * HALF + m * 16; const size_t ro = (size_t)row * ldc + col0; float s = 0.f;
#pragma unroll
                for (int bj = 0; bj < 2; ++bj)
#pragma unroll
                    for (int n = 0; n < 2; ++n) { const f32x4 r = *(const f32x4*)(R + ro + bj * HALF + n * 16); const f32x4 y = acc[ai][bj][m][n] + r; *(f32x4*)(C + ro + bj * HALF + n * 16) = y;
                        if (STATS) { s += y[0] * y[0] + y[1] * y[1] + y[2] * y[2] + y[3] * y[3];
                            unsigned w0 = cvt_pk_bf16(y[0], y[1]), w1 = cvt_pk_bf16(y[2], y[3]);
                            *(unsigned long long*)(XB + (size_t)row * 1024 + col0 + bj * HALF + n * 16) = (unsigned long long)w0 | ((unsigned long long)w1 << 32); } }
                if (STATS) {
                    s += __int_as_float(__builtin_amdgcn_ds_swizzle(__float_as_int(s), (16 << 10) | 0x1f));
                    auto rr = __builtin_amdgcn_permlane32_swap(__float_as_uint(s), __float_as_uint(s), false, false);
                    s = __uint_as_float(rr[0]) + __uint_as_float(rr[1]);
                    if (fq == 0) atomicAdd(ss + row, s);
                } }
    }
};

template <class Epi, class Sched>
__device__ __forceinline__ void gemm_phase(const int tid, PG8_LAS unsigned char* lds, const Gemm g, const Sched& S, const Epi& E) {
    constexpr bool STAMP = false; unsigned long long* stamps = nullptr;
    const int wid = __builtin_amdgcn_readfirstlane(tid >> 6), lane = tid & 63, wr = wid >> 2, wc = wid & 3, fr = lane & 15, fq = lane >> 4;
    const int K = g.K, nt = K / BK;
    int ts_lo = 0, ts_hi = 0, nts = 0; const unsigned long long rt_entry = STAMP ? (unsigned long long)wall_clock64_() : 0ull;
#define PG8_STAMP() do { if (STAMP && wid == 0 && nts < 64) { const unsigned long long _c = (unsigned long long)clock64(); \
        ts_lo = (lane == nts) ? (int)(unsigned)_c : ts_lo; ts_hi = (lane == nts) ? (int)(unsigned)(_c >> 32) : ts_hi; ++nts; } } while (0)
    PG8_STAMP();
    unsigned voffA[2], voffB[2];
#pragma unroll
    for (int i = 0; i < 2; ++i) { int R, C; stage_rc(tid * 16 + i * 8192, R, C); const int Rb = Epi::PERM ? ((R & ~31) + perm32(R & 31)) : R;
        voffA[i] = (unsigned)(R * K + C) * 2u; voffB[i] = (unsigned)(Rb * K + C) * 2u; }
    const size_t kstep = (size_t)(BK * 2);
    const size_t hstep = (size_t)HALF * K * 2;
    const size_t tstep = 2 * hstep;
    const unsigned ldsw = (unsigned)wid * 1024u;
    const int aoff = lds_byte(wr * 64 + fr, fq * 8), boff = lds_byte(wc * 32 + fr, fq * 8);
#define PG8_SA(b, h) (((b) * 2 + (h)) * HTB)
#define PG8_SB(b, h) ((4 + (b) * 2 + (h)) * HTB)
#define PG8_STAGE(bufoff, gbase, voff) do { _Pragma("unroll") for (int _i = 0; _i < 2; ++_i) \
        __builtin_amdgcn_global_load_lds((const unsigned*)((const char*)(gbase) + (voff)[_i]), (PG8_LAS unsigned*)(lds + (bufoff) + ldsw + _i * 8192), 16, 0, 0); } while (0)
#define PG8_LDA(dst, b, h) do { _Pragma("unroll") for (int m = 0; m < 4; ++m) _Pragma("unroll") for (int k = 0; k < 2; ++k) dst[m][k] = *(const PG8_LAS bf16x8*)(lds + PG8_SA(b, h) + aoff + m * 2048 + k * 1024); } while (0)
#define PG8_LDB(dst, b, h) do { _Pragma("unroll") for (int n = 0; n < 2; ++n) _Pragma("unroll") for (int k = 0; k < 2; ++k) dst[n][k] = *(const PG8_LAS bf16x8*)(lds + PG8_SB(b, h) + boff + n * 2048 + k * 1024); } while (0)
#define PG8_MMA(ai, bj, At, Bt) do { __builtin_amdgcn_s_setprio(1); _Pragma("unroll") for (int m = 0; m < 4; ++m) _Pragma("unroll") for (int n = 0; n < 2; ++n) _Pragma("unroll") for (int k = 0; k < 2; ++k) \
        acc[ai][bj][m][n] = __builtin_amdgcn_mfma_f32_16x16x32_bf16(Bt[n][k], At[m][k], acc[ai][bj][m][n], 0, 0, 0); __builtin_amdgcn_s_setprio(0); } while (0)
#define PG8_WAIT_V(n) asm volatile("s_waitcnt vmcnt(" #n ")" ::: "memory")
#define PG8_WAIT_L(n) asm volatile("s_waitcnt lgkmcnt(" #n ")" ::: "memory")
#define PG8_BAR __builtin_amdgcn_s_barrier()
#define PG8_SCHED __builtin_amdgcn_sched_barrier(0)
    Unit cur, nxt; int ui = 0;
    if (!S.next(0, cur)) return;
    f32x4 acc[2][2][4][2];
#pragma unroll
    for (int a = 0; a < 2; ++a)
#pragma unroll
        for (int b = 0; b < 2; ++b)
#pragma unroll
            for (int m = 0; m < 4; ++m)
#pragma unroll
                for (int n = 0; n < 2; ++n) acc[a][b][m][n] = (f32x4){0.f, 0.f, 0.f, 0.f};
    bf16x8 At[4][2], B0[2][2], B1[2][2];
    const char* cA = (const char*)g.A + (size_t)cur.pm * tstep; const char* cB = (const char*)g.Bt + (size_t)cur.pn * tstep;
    S.a_ready(cur);
    PG8_STAGE(PG8_SB(0, 0), cB, voffB); PG8_STAGE(PG8_SA(0, 0), cA, voffA); PG8_STAGE(PG8_SB(0, 1), cB + hstep, voffB); PG8_STAGE(PG8_SA(0, 1), cA + hstep, voffA);
    if (wr == 1) PG8_BAR;
    PG8_WAIT_V(4); PG8_BAR;
    PG8_STAGE(PG8_SB(1, 0), cB + kstep, voffB); PG8_STAGE(PG8_SA(1, 0), cA + kstep, voffA); PG8_STAGE(PG8_SB(1, 1), cB + hstep + kstep, voffB);
    PG8_WAIT_V(6); PG8_BAR;
    PG8_STAMP();
    for (;;) {
        const bool has_next = S.next(ui + 1, nxt);
        const char* nA = has_next ? (const char*)g.A + (size_t)nxt.pm * tstep : cA; const char* nB = has_next ? (const char*)g.Bt + (size_t)nxt.pn * tstep : cB;
        for (int t = 0; t < nt; t += 2) {
            const bool last = (t == nt - 2);
            const char* a1 = cA + (size_t)(t + 1) * kstep;
            const char* a2 = last ? nA : cA + (size_t)(t + 2) * kstep; const char* b2 = last ? nB : cB + (size_t)(t + 2) * kstep;
            const char* a3 = a2 + kstep; const char* b3 = b2 + kstep;
            if (last && has_next) S.a_ready(nxt);
            PG8_LDB(B0, 0, 0); PG8_SCHED; PG8_LDA(At, 0, 0); PG8_STAGE(PG8_SA(1, 1), a1 + hstep, voffA);
            PG8_WAIT_L(8); PG8_BAR; PG8_WAIT_L(0); PG8_MMA(0, 0, At, B0); PG8_BAR; PG8_SCHED;
            PG8_LDB(B1, 0, 1); PG8_STAGE(PG8_SB(0, 0), b2, voffB);
            PG8_BAR; PG8_WAIT_L(0); PG8_MMA(0, 1, At, B1); PG8_BAR;
            PG8_LDA(At, 0, 1); PG8_STAGE(PG8_SA(0, 0), a2, voffA);
            PG8_BAR; PG8_WAIT_L(0); PG8_MMA(1, 0, At, B0); PG8_BAR; PG8_SCHED;
            PG8_STAGE(PG8_SB(0, 1), b2 + hstep, voffB);
            PG8_WAIT_V(6); PG8_BAR; PG8_MMA(1, 1, At, B1); PG8_BAR;
            PG8_LDB(B0, 1, 0); PG8_SCHED; PG8_LDA(At, 1, 0); PG8_STAGE(PG8_SA(0, 1), a2 + hstep, voffA);
            PG8_WAIT_L(8); PG8_BAR; PG8_WAIT_L(0); PG8_MMA(0, 0, At, B0); PG8_BAR; PG8_SCHED;
            PG8_LDB(B1, 1, 1); PG8_STAGE(PG8_SB(1, 0), b3, voffB);
            PG8_BAR; PG8_WAIT_L(0); PG8_MMA(0, 1, At, B1); PG8_BAR;
            PG8_LDA(At, 1, 1); PG8_STAGE(PG8_SA(1, 0), a3, voffA);
            PG8_BAR; PG8_WAIT_L(0); PG8_MMA(1, 0, At, B0); PG8_BAR; PG8_SCHED;
            PG8_STAGE(PG8_SB(1, 1), b3 + hstep, voffB);
            PG8_WAIT_V(6); PG8_BAR; PG8_MMA(1, 1, At, B1); PG8_BAR;
        }
        PG8_STAMP();
        if constexpr (!Epi::AFTER_DRAIN) { E(acc, cur, wr, wc, fr, fq); S.done(cur); }
        PG8_STAMP();
        if (!has_next) break;
#pragma unroll
        for (int a = 0; a < 2; ++a)
#pragma unroll
            for (int b = 0; b < 2; ++b)
#pragma unroll
                for (int m = 0; m < 4; ++m)
#pragma unroll
                    for (int n = 0; n < 2; ++n) acc[a][b][m][n] = (f32x4){0.f, 0.f, 0.f, 0.f};
        cur = nxt; cA = nA; cB = nB; ++ui;
    }
    PG8_WAIT_V(0);
    if (wr == 0) PG8_BAR;
    PG8_BAR;
    if constexpr (Epi::AFTER_DRAIN) { E.fused(acc, cur, wr, wc, fr, fq, lds, wid, lane); S.done(cur); }
    PG8_STAMP();
    if (STAMP && wid == 0) { stamps[lane] = lane < nts ? (((unsigned long long)(unsigned)ts_hi << 32) | (unsigned)ts_lo) : 0ull;
        if (lane == 62) stamps[62] = rt_entry; if (lane == 63) stamps[63] = (unsigned long long)wall_clock64_(); }
#undef PG8_STAMP
#undef PG8_SA
#undef PG8_SB
#undef PG8_STAGE
#undef PG8_LDA
#undef PG8_LDB
#undef PG8_MMA
#undef PG8_WAIT_V
#undef PG8_WAIT_L
#undef PG8_BAR
#undef PG8_SCHED
}
}

constexpr float ATT_SCALE = 0.07216878364870323f;
constexpr float ATT_THR = 8.f;
constexpr int SHM_V = 16384, SHM_K = 24576;
constexpr int LDQ = 3072, LDKV = 4096, LDO = 2048;

template <bool NA = false>
DI void partialSM(f32x16& p0, f32x16& p1, float& m_reg, float& mn, float& alpha) {
  constexpr float C = (NA ? 1.f : ATT_SCALE) * 1.4426950408889634f;
  float pmax = p0[0];
#pragma unroll
  for (int r = 1; r < 16; ++r) pmax = fmaxf(pmax, p0[r]);
#pragma unroll
  for (int r = 0; r < 16; ++r) pmax = fmaxf(pmax, p1[r]);
  { auto rr = __builtin_amdgcn_permlane32_swap(__float_as_uint(pmax), __float_as_uint(pmax), false, false);
    pmax = fmaxf(__uint_as_float(rr[0]), __uint_as_float(rr[1])); }
  if (__builtin_expect(__all(pmax - m_reg <= ATT_THR / (NA ? 1.f : ATT_SCALE)), 1)) { mn = m_reg; alpha = 1.f; }
  else { mn = fmaxf(m_reg, pmax); alpha = __builtin_amdgcn_exp2f((m_reg - mn) * C); m_reg = mn; }
  const float mnC = -mn * C;
#pragma unroll
  for (int r = 0; r < 16; ++r) p0[r] = fmaf(p0[r], C, mnC);
#pragma unroll
  for (int r = 0; r < 16; ++r) p1[r] = fmaf(p1[r], C, mnC);
#pragma unroll
  for (int r = 0; r < 16; ++r) p0[r] = __builtin_amdgcn_exp2f(p0[r]);
}
DI void finishSM(f32x16& p0, f32x16& p1, float alpha, float& l_reg, bf16x8& pa0, bf16x8& pa1, bf16x8& pa2, bf16x8& pa3) {
#pragma unroll
  for (int r = 0; r < 16; ++r) p1[r] = __builtin_amdgcn_exp2f(p1[r]);
  float ps = 0;
#pragma unroll
  for (int r = 0; r < 16; ++r) ps += p0[r];
#pragma unroll
  for (int r = 0; r < 16; ++r) ps += p1[r];
  { auto rr = __builtin_amdgcn_permlane32_swap(__float_as_uint(ps), __float_as_uint(ps), false, false);
    ps = __uint_as_float(rr[0]) + __uint_as_float(rr[1]); }
  l_reg = l_reg * alpha + ps;
#define PK4(P, BASE, OUT) do { unsigned a0 = cvtpk(P[BASE + 0], P[BASE + 1]), a1 = cvtpk(P[BASE + 2], P[BASE + 3]);   \
    unsigned b0 = cvtpk(P[BASE + 4], P[BASE + 5]), b1 = cvtpk(P[BASE + 6], P[BASE + 7]);                              \
    auto r0 = __builtin_amdgcn_permlane32_swap(a0, b0, false, false); auto r1 = __builtin_amdgcn_permlane32_swap(a1, b1, false, false); \
    u32x4 w = {r0[0], r1[0], r0[1], r1[1]}; OUT = __builtin_bit_cast(bf16x8, w); } while (0)
  PK4(p0, 0, pa0); PK4(p0, 8, pa1); PK4(p1, 0, pa2); PK4(p1, 8, pa3);
#undef PK4
}
DI void qkt(f32x16& p0, f32x16& p1, const char* Ks, const bf16x8* qr, const char* Qs, int k0, int k1, int k2, int k3) {
#pragma unroll
  for (int r = 0; r < 16; ++r) { p0[r] = 0.f; p1[r] = 0.f; }
#pragma unroll
  for (int d0 = 0; d0 < 12; ++d0) {
    const int off = ((d0 & 3) == 0 ? k0 : (d0 & 3) == 1 ? k1 : (d0 & 3) == 2 ? k2 : k3) + (d0 >> 2) * 128;
    const bf16x8 b0 = *(const bf16x8*)(Ks + off);
    const bf16x8 b1 = *(const bf16x8*)(Ks + off + 32 * 384);
    const bf16x8 qv = d0 < 8 ? qr[d0 & 7] : *(const bf16x8*)(Qs + (d0 - 8) * 1024);
    p0 = MFMA32(b0, qv, p0);
    p1 = MFMA32(b1, qv, p1);
  }
}
DI int v_st(int k, int c) { const int kk = (k & ~0xC) | ((k & 4) << 1) | ((k & 8) >> 1); return ((kk >> 3) * 4 + (c >> 5)) * 512 + ((kk & 7) * 32 + (c & 31)) * 2; }
DI int v_rd_base(int lane) { return ((lane & 3) << 3) | (((lane >> 2) & 3) << 6) | (((lane >> 4) & 1) << 5) | (((lane >> 5) & 1) << 8); }
constexpr int v_rd_off(int d0, int ks, int half) { return d0 * 512 + ks * 4096 + half * 2048; }
template <int OFF> DI s16x4 tr_read(int vb) {
  s16x4 r; asm volatile("ds_read_b64_tr_b16 %0, %1 offset:%2" : "=&v"(r) : "v"(vb), "i"(OFF) : "memory"); return r;
}
template <int D0> DI void pv_one(f32x16& od, int vb, bf16x8 pa0, bf16x8 pa1, bf16x8 pa2, bf16x8 pa3) {
  const s16x4 l0 = tr_read<v_rd_off(D0, 0, 0)>(vb), h0 = tr_read<v_rd_off(D0, 0, 1)>(vb), l1 = tr_read<v_rd_off(D0, 1, 0)>(vb), h1 = tr_read<v_rd_off(D0, 1, 1)>(vb);
  const s16x4 l2 = tr_read<v_rd_off(D0, 2, 0)>(vb), h2 = tr_read<v_rd_off(D0, 2, 1)>(vb), l3 = tr_read<v_rd_off(D0, 3, 0)>(vb), h3 = tr_read<v_rd_off(D0, 3, 1)>(vb);
  asm volatile("s_waitcnt lgkmcnt(0)" ::: "memory"); SBAR();
#define PK(L, H) (bf16x8){L[0], L[1], L[2], L[3], H[0], H[1], H[2], H[3]}
  od = MFMA32(pa0, PK(l0, h0), od);
  od = MFMA32(pa1, PK(l1, h1), od);
  od = MFMA32(pa2, PK(l2, h2), od);
  od = MFMA32(pa3, PK(l3, h3), od);
#undef PK
}
DI void pv_d0(f32x16* o, int vb, bf16x8 pa0, bf16x8 pa1, bf16x8 pa2, bf16x8 pa3) {
  pv_one<0>(o[0], vb, pa0, pa1, pa2, pa3); pv_one<1>(o[1], vb, pa0, pa1, pa2, pa3); pv_one<2>(o[2], vb, pa0, pa1, pa2, pa3); pv_one<3>(o[3], vb, pa0, pa1, pa2, pa3);
}

template <int H> DI void qkt_half(f32x16& p0, f32x16& p1, const char* Ks, const bf16x8* qr, const char* Qs, int k0, int k1, int k2, int k3, float negm = 0.f) {
  if (H == 0) {
#pragma unroll
    for (int r = 0; r < 16; ++r) { p0[r] = negm; p1[r] = negm; }
  }
#pragma unroll
  for (int d0 = 6 * H; d0 < 6 * H + 6; ++d0) {
    const int off = ((d0 & 3) == 0 ? k0 : (d0 & 3) == 1 ? k1 : (d0 & 3) == 2 ? k2 : k3) + (d0 >> 2) * 128;
    const bf16x8 b0 = *(const bf16x8*)(Ks + off);
    const bf16x8 b1 = *(const bf16x8*)(Ks + off + 32 * 384);
    const bf16x8 qv = d0 < 8 ? qr[d0 & 7] : *(const bf16x8*)(Qs + (d0 - 8) * 1024);
    p0 = MFMA32(b0, qv, p0);
    p1 = MFMA32(b1, qv, p1);
  }
}
template <bool P0HI = false>
DI void finish_part(f32x16& p0, f32x16& p1, float alpha, float& l_reg) {
  if (P0HI) {
#pragma unroll
    for (int r = 0; r < 16; ++r) p0[r] = __builtin_amdgcn_exp2f(p0[r]);
  }
#pragma unroll
  for (int r = 0; r < 16; ++r) p1[r] = __builtin_amdgcn_exp2f(p1[r]);
  float ps = 0;
#pragma unroll
  for (int r = 0; r < 16; ++r) ps += p0[r];
#pragma unroll
  for (int r = 0; r < 16; ++r) ps += p1[r];
  { auto rr = __builtin_amdgcn_permlane32_swap(__float_as_uint(ps), __float_as_uint(ps), false, false);
    ps = __uint_as_float(rr[0]) + __uint_as_float(rr[1]); }
  l_reg = l_reg * alpha + ps;
}
template <int BASE> DI bf16x8 pack8(const f32x16& P) {
  u32x4 w = {cvtpk(P[BASE + 0], P[BASE + 1]), cvtpk(P[BASE + 2], P[BASE + 3]), cvtpk(P[BASE + 4], P[BASE + 5]), cvtpk(P[BASE + 6], P[BASE + 7])};
  return __builtin_bit_cast(bf16x8, w);
}
DI float sm_max(const f32x16& p0, const f32x16& p1) {
  float pmax = p0[0];
#pragma unroll
  for (int r = 1; r < 16; ++r) pmax = fmaxf(pmax, p0[r]);
#pragma unroll
  for (int r = 0; r < 16; ++r) pmax = fmaxf(pmax, p1[r]);
  auto rr = __builtin_amdgcn_permlane32_swap(__float_as_uint(pmax), __float_as_uint(pmax), false, false);
  return fmaxf(__uint_as_float(rr[0]), __uint_as_float(rr[1]));
}
constexpr float ATT_C = ATT_SCALE * 1.4426950408889634f;
constexpr float ATT_THR2 = ATT_THR * 1.4426950408889634f;
DI void sm_decide2(float pmax, float& m2, float& alpha, f32x16& p0, f32x16& p1) {
  alpha = 1.f;
  if (__builtin_expect(!__all(pmax <= ATT_THR2), 0)) {
    const float shift = fmaxf(pmax, 0.f);
#pragma unroll
    for (int r = 0; r < 16; ++r) { p0[r] -= shift; p1[r] -= shift; }
    alpha = __builtin_amdgcn_exp2f(-shift); m2 += shift;
  }
}
template <int LO> DI void sm_exp8(f32x16& p) {
#pragma unroll
  for (int r = LO; r < LO + 8; ++r) p[r] = __builtin_amdgcn_exp2f(p[r]);
}

constexpr int ATT_VOFF = 0, ATT_KOFF = 3 * SHM_V, ATT_WOFF = ATT_KOFF + 2 * SHM_K, ATT_QOFF = ATT_WOFF + 2048, ATT_LDS_END = ATT_QOFF + 32768;
static_assert(ATT_LDS_END <= LDS_BYTES, "attention LDS");
#define LAS3 __attribute__((address_space(3)))
DI void attn_tile(int tid__, int bid__, const u16* __restrict__ Qb, const u16* __restrict__ Kh, const u16* __restrict__ Vh, const u16* __restrict__ KRb, u16* __restrict__ Ob, int seq, char* lds) {
  const int tid = tid__, wid = __builtin_amdgcn_readfirstlane(tid >> 6), lane = tid & 63, r32 = lane & 31, hi = lane >> 5;
  char* V_lds = lds + ATT_VOFF; char* K_lds = lds + ATT_KOFF;
  float* wsf = (float*)(lds + ATT_WOFF) + wid * 64; float* li_l = wsf; float* al_l = wsf + 32;
  float m_reg = -1e30f, l_reg = 0; f32x16 o[4]; bf16x8 qr[8];
#pragma unroll
  for (int d = 0; d < 4; ++d)
#pragma unroll
    for (int r = 0; r < 16; ++r) o[d][r] = 0.f;
  const u16* Qw = Qb + (long)(wid * 32 + r32) * LDQ + hi * 8;
  char* Qs = lds + ATT_QOFF + wid * 4096 + lane * 16;
  const char* const kbase = (const char*)KRb; const unsigned dK = (unsigned)((const char*)Kh - (const char*)KRb);
  const char* vbase = (const char*)Vh;
  unsigned ko0, ko1, ko2, kstp0, kstp1, kstp2;
#define KSRC(i, KO, KS) do { const int p_ = (i) * 512 + tid, row_ = p_ / 24, cpos_ = p_ - row_ * 24, c_ = (cpos_ & ~7) | ((cpos_ & 7) ^ ((row_ >> 1) & 7)); \
    const bool np_ = cpos_ < 16; KO = np_ ? dK + (unsigned)(row_ * (LDKV * 2) + c_ * 16) : (unsigned)(row_ * 128 + (c_ - 16) * 16); KS = np_ ? 64u * LDKV * 2u : 64u * 64u * 2u; } while (0)
  KSRC(0, ko0, kstp0); KSRC(1, ko1, kstp1); KSRC(2, ko2, kstp2);
#undef KSRC
  unsigned vo0;
#define VSRC(i, VO) do { const int p_ = (i) * 512 + tid, kk_ = ((p_ >> 7) << 3) | ((p_ >> 2) & 7), k_ = kk_  , c_ = (((p_ >> 5) & 3) << 5) | ((p_ & 3) << 3); \
    VO = (unsigned)(k_ * (LDKV * 2) + c_ * 2); } while (0)
  VSRC(0, vo0);
#undef VSRC
  const int vb0 = (int)(uintptr_t)V_lds + v_rd_base(lane);
  const int xs = ((r32 >> 1) & 7) << 4, kb = r32 * 384;
  const int k0 = kb + ((hi * 16) ^ xs), k1 = kb + ((32 + hi * 16) ^ xs), k2 = kb + ((64 + hi * 16) ^ xs), k3 = kb + ((96 + hi * 16) ^ xs);
  LAS3 char* const ldsK = (LAS3 char*)lds + ATT_KOFF + wid * 1024; LAS3 char* const ldsV = (LAS3 char*)lds + ATT_VOFF + wid * 1024;
#define DMA(kb_, vo_) do { \
    __builtin_amdgcn_global_load_lds((const unsigned*)(kbase + ko0), (LAS3 unsigned*)(ldsK + (kb_) * SHM_K), 16, 0, 0); \
    __builtin_amdgcn_global_load_lds((const unsigned*)(kbase + ko1), (LAS3 unsigned*)(ldsK + (kb_) * SHM_K + 8192), 16, 0, 0); \
    __builtin_amdgcn_global_load_lds((const unsigned*)(kbase + ko2), (LAS3 unsigned*)(ldsK + (kb_) * SHM_K + 16384), 16, 0, 0); \
    __builtin_amdgcn_global_load_lds((const unsigned*)(vbase + vo0), (LAS3 unsigned*)(ldsV + (vo_)), 16, 0, 0); \
    __builtin_amdgcn_global_load_lds((const unsigned*)(vbase + 32 * LDKV * 2 + vo0), (LAS3 unsigned*)(ldsV + (vo_) + 8192), 16, 0, 0); \
    ko0 += kstp0; ko1 += kstp1; ko2 += kstp2; vbase += 64 * LDKV * 2; } while (0)
#define VNEXT(x) do { x += SHM_V; if (x == 3 * SHM_V) x = 0; } while (0)
#define STEP_END() do { asm volatile("s_waitcnt vmcnt(0)" ::: "memory"); __syncthreads(); } while (0)
#define RESC(a) do { if (__any((a) < 1.f)) { _Pragma("unroll") for (int d = 0; d < 4; ++d) _Pragma("unroll") for (int r = 0; r < 16; ++r) o[d][r] *= (a); } } while (0)
  f32x16 pA0, pA1, pB0, pB1; float mnA, mnB, alA, alB; bf16x8 pa0, pa1, pa2, pa3; const int NT = seq / 64;
  asm volatile("s_waitcnt lgkmcnt(0)" ::: "memory"); __builtin_amdgcn_s_barrier(); asm volatile("" ::: "memory");
  int vwr = 0, vrd = 0;
  DMA(0, vwr); VNEXT(vwr);
  DMA(1, vwr); VNEXT(vwr);
#pragma unroll
  for (int d0 = 0; d0 < 8; ++d0) qr[d0] = *(const bf16x8*)(Qw + d0 * 16);
  {
    bf16x8 qx[4];
#pragma unroll
    for (int i = 0; i < 4; ++i) qx[i] = *(const bf16x8*)(Qw + 128 + i * 16);
    asm volatile("s_waitcnt vmcnt(0)" ::: "memory");
#pragma unroll
    for (int i = 0; i < 4; ++i) *(bf16x8*)(Qs + i * 1024) = qx[i];
  }
  __syncthreads();
  qkt_half<0>(pA0, pA1, K_lds, qr, Qs, k0, k1, k2, k3); qkt_half<1>(pA0, pA1, K_lds, qr, Qs, k0, k1, k2, k3);
  { m_reg = sm_max(pA0, pA1);
#pragma unroll
    for (int r = 0; r < 16; ++r) { pA0[r] -= m_reg; pA1[r] -= m_reg; }
    alA = 1.f; }
  STEP_END();
#define PV_READS(KS) const s16x4 l0_ = tr_read<v_rd_off(0, KS, 0)>(vbv), h0_ = tr_read<v_rd_off(0, KS, 1)>(vbv), l1_ = tr_read<v_rd_off(1, KS, 0)>(vbv), h1_ = tr_read<v_rd_off(1, KS, 1)>(vbv), \
    l2_ = tr_read<v_rd_off(2, KS, 0)>(vbv), h2_ = tr_read<v_rd_off(2, KS, 1)>(vbv), l3_ = tr_read<v_rd_off(3, KS, 0)>(vbv), h3_ = tr_read<v_rd_off(3, KS, 1)>(vbv)
#define PKV(L, H) (bf16x8){L[0], L[1], L[2], L[3], H[0], H[1], H[2], H[3]}
#define PV_MFMA(PA) do { asm volatile("s_waitcnt lgkmcnt(0)" ::: "memory"); SBAR(); \
    o[0] = MFMA32(PKV(l0_, h0_), PA, o[0]); o[1] = MFMA32(PKV(l1_, h1_), PA, o[1]); o[2] = MFMA32(PKV(l2_, h2_), PA, o[2]); o[3] = MFMA32(PKV(l3_, h3_), PA, o[3]); } while (0)
#define ATT_STEP(C0, C1, P0, P1, ALP, ALC, KOFF, KBI, DO_DMA) do { \
    SBAR(); qkt_half<0>(C0, C1, K_lds + (KOFF), qr, Qs, k0, k1, k2, k3, -m_reg); __builtin_amdgcn_sched_barrier(0x7); \
    if (DO_DMA) { DMA(KBI, vwr); VNEXT(vwr); } __builtin_amdgcn_sched_barrier(0x7); \
    qkt_half<1>(C0, C1, K_lds + (KOFF), qr, Qs, k0, k1, k2, k3); \
    finish_part<true>(P0, P1, ALP, l_reg); pa0 = pack8<0>(P0); SBAR(); \
    const int vbv = vb0 + vrd; float pmax_; \
    { PV_READS(0); pa1 = pack8<8>(P0); pmax_ = sm_max(C0, C1); PV_MFMA(pa0); } SBAR(); \
    sm_decide2(pmax_, m_reg, ALC, C0, C1); SBAR(); \
    { PV_READS(1); pa2 = pack8<0>(P1); PV_MFMA(pa1); } SBAR(); \
    { PV_READS(2); pa3 = pack8<8>(P1); PV_MFMA(pa2); } SBAR(); \
    { PV_READS(3); PV_MFMA(pa3); } asm volatile("" : "+v"(C0), "+v"(C1)); SBAR(); \
    VNEXT(vrd); RESC(ALC); } while (0)
  for (int j = 1; j + 1 < NT; j += 2) {
    ATT_STEP(pB0, pB1, pA0, pA1, alA, alB, SHM_K, 0, true); STEP_END();
    ATT_STEP(pA0, pA1, pB0, pB1, alB, alA, 0, 1, true); STEP_END();
  }
  ATT_STEP(pB0, pB1, pA0, pA1, alA, alB, SHM_K, 0, false);
#undef ATT_STEP
  finish_part<true>(pB0, pB1, alB, l_reg); pa0 = pack8<0>(pB0); pa1 = pack8<8>(pB0); pa2 = pack8<0>(pB1); pa3 = pack8<8>(pB1); SBAR();
  { const int vbv = vb0 + vrd;
    { PV_READS(0); PV_MFMA(pa0); } SBAR(); { PV_READS(1); PV_MFMA(pa1); } SBAR(); { PV_READS(2); PV_MFMA(pa2); } SBAR(); { PV_READS(3); PV_MFMA(pa3); } }
#undef PV_MFMA
#undef PKV
#undef PV_READS
  { const float rl = __builtin_amdgcn_rcpf(l_reg);
    u16* Ow = Ob + (long)(wid * 32 + r32) * LDO + 4 * hi;
#pragma unroll
    for (int d0 = 0; d0 < 4; ++d0)
#pragma unroll
      for (int gq = 0; gq < 4; ++gq) {
        u32x2 w; w[0] = cvtpk(o[d0][4 * gq] * rl, o[d0][4 * gq + 1] * rl); w[1] = cvtpk(o[d0][4 * gq + 2] * rl, o[d0][4 * gq + 3] * rl);
        *(u32x2*)(Ow + d0 * 32 + gq * 8) = w; } }
#undef VNEXT
#undef STEP_END
#undef RESC
}

DI void phase_attn(int tid__, int bid__, const u16* Q, const u16* KV, const u16* KRc, u16* O, int c, char* lds) {
  for (int v = bid__; v < 1024; v += gridDim.x) {
    const int x = v & 7, slot = (v >> 3) & 31, rnd = v >> 8;
    int h, tok0, key0, seq;
    if (c < 2) { h = x + 8 * (rnd >> 1); const int qb = slot + 32 * (rnd & 1); tok0 = qb * 256; key0 = 0; seq = 16384; }
    else { const int pr = x + 8 * (2 * rnd + (slot >> 4)); const int b = pr >> 4; h = pr & 15; key0 = b * 4096; tok0 = key0 + (slot & 15) * 256; seq = 4096; }
    attn_tile(tid__, bid__, Q + (long)tok0 * LDQ + h * 192, KV + (long)key0 * LDKV + h * 256, KV + (long)key0 * LDKV + h * 256 + 128, KRc + (long)key0 * 64,
              O + (long)tok0 * LDO + h * 128, seq, lds);
  }
}

DI int v_st64(int k, int c) { const int kk = (k & ~0xC) | ((k & 4) << 1) | ((k & 8) >> 1); return ((kk >> 3) * 2 + (c >> 5)) * 512 + ((kk & 7) * 32 + (c & 31)) * 2; }
constexpr int v_rd_off64(int d0, int ks, int half) { return d0 * 512 + ks * 2048 + half * 1024; }
template <int D0> DI void pv_one64(f32x16& od, int vb, bf16x8 pa0, bf16x8 pa1, bf16x8 pa2, bf16x8 pa3) {
  const s16x4 l0 = tr_read<v_rd_off64(D0, 0, 0)>(vb), h0 = tr_read<v_rd_off64(D0, 0, 1)>(vb), l1 = tr_read<v_rd_off64(D0, 1, 0)>(vb), h1 = tr_read<v_rd_off64(D0, 1, 1)>(vb);
  const s16x4 l2 = tr_read<v_rd_off64(D0, 2, 0)>(vb), h2 = tr_read<v_rd_off64(D0, 2, 1)>(vb), l3 = tr_read<v_rd_off64(D0, 3, 0)>(vb), h3 = tr_read<v_rd_off64(D0, 3, 1)>(vb);
  asm volatile("s_waitcnt lgkmcnt(0)" ::: "memory"); SBAR();
#define PK(L, H) (bf16x8){L[0], L[1], L[2], L[3], H[0], H[1], H[2], H[3]}
  od = MFMA32(pa0, PK(l0, h0), od);
  od = MFMA32(pa1, PK(l1, h1), od);
  od = MFMA32(pa2, PK(l2, h2), od);
  od = MFMA32(pa3, PK(l3, h3), od);
#undef PK
}
DI void phase_na(int tid__, int bid__, const u16* __restrict__ QKV, const float* __restrict__ rpb, u16* __restrict__ O, char* lds) {
  const int tid = tid__, wid = tid >> 6, lane = tid & 63, r32 = lane & 31, hi = lane >> 5;
  const int hp = wid >> 1, m = wid & 1;
  char* K_l = lds; char* V_l = lds + 32768;
  float* rp = (float*)(lds + 131072);
  float* wsf = (float*)(lds + 131072 + 7680) + wid * 64; float* li_l = wsf; float* al_l = wsf + 32;
  const int c = m * 32 + r32, cs = min(max(c - 8, 0), 48);
  const int stok = tid >> 5, cidx = tid & 31, shead = cidx >> 3, sch = cidx & 7;
  const int kst = shead * 8192 + stok * 128 + ((sch ^ ((stok >> 1) & 7)) << 4);
  const int vst = 32768 + shead * 8192 + v_st64(stok, sch * 8);
  const int krd = hp * 8192 + r32 * 128, kx = (r32 >> 1) & 7;
  const int vb = (int)(uintptr_t)V_l + hp * 8192 + v_rd_base(lane);
  for (int v = bid__; v < 3072; v += gridDim.x) {
    const int x = v & 7, rest = v >> 3, g = x * 96 + (rest % 96), hb = (rest / 96) * 4, h = hb + hp;
    int rows, r, seqbase;
    if (g < 512) { rows = 256; r = g & 255; seqbase = (g >> 8) * 16384; } else { rows = 64; r = (g - 512) & 63; seqbase = TP + ((g - 512) >> 6) * 4096; }
    const int r0 = min(max(r - 4, 0), rows - 8);
    const u16* kbase = QKV + (long)(seqbase + r0 * 64 + stok) * 3072 + 1024 + hb * 64 + cidx * 8;
    bf16x8 kr0[4], vr0[4], kr1[4], vr1[4];
#define NA_LOAD(KR, VR, i) do { _Pragma("unroll") for (int it = 0; it < 4; ++it) { const u16* s_ = kbase + (long)((i) * 64 + 16 * it) * 3072; KR[it] = *(const bf16x8*)s_; VR[it] = *(const bf16x8*)(s_ + 1024); } } while (0)
    NA_LOAD(kr0, vr0, 0); NA_LOAD(kr1, vr1, 1);
    bf16x8 qr[4];
    { const u16* qp = QKV + (long)(seqbase + r * 64 + c) * 3072 + h * 64 + hi * 8;
#pragma unroll
      for (int d0 = 0; d0 < 4; ++d0) qr[d0] = *(const bf16x8*)(qp + d0 * 16); }
    __syncthreads();
    for (int i = tid; i < 1860; i += NTHR) rp[i] = rpb[hb * 465 + i];
    float m_reg = -1e30f, l_reg = 0.f; f32x16 o[2];
#pragma unroll
    for (int d = 0; d < 2; ++d)
#pragma unroll
      for (int rr = 0; rr < 16; ++rr) o[d][rr] = 0.f;
#pragma unroll 1
    for (int i2 = 0; i2 < 8; i2 += 2) {
      { const int i = i2, so = 0;
#pragma unroll
        for (int it = 0; it < 4; ++it) { *(bf16x8*)(lds + so + kst + it * 2048) = kr0[it]; *(bf16x8*)(lds + so + vst + it * 2048) = vr0[it]; }
        if (i + 2 < 8) NA_LOAD(kr0, vr0, i + 2);
        __syncthreads();
      f32x16 p0, p1;
#pragma unroll
      for (int rr = 0; rr < 16; ++rr) { p0[rr] = 0.f; p1[rr] = 0.f; }
#pragma unroll
      for (int d0 = 0; d0 < 4; ++d0) {
        const int co = ((d0 * 2 + hi) ^ kx) << 4;
        const bf16x8 b0 = *(const bf16x8*)(K_l + so + krd + co);
        const bf16x8 b1 = *(const bf16x8*)(K_l + so + krd + 4096 + co);
        p0 = MFMA32(b0, qr[d0], p0);
        p1 = MFMA32(b1, qr[d0], p1);
      }
      const float* rph = rp + hp * 465 + (r0 + i - r + 7) * 31 + 15 - c;
      { float bv[16];
#pragma unroll
        for (int rr = 0; rr < 16; ++rr) bv[rr] = rph[crow(rr, hi)];
#pragma unroll
        for (int rr = 0; rr < 16; ++rr) { const float s0 = fmaf(p0[rr], 0.125f, bv[rr]); p0[rr] = ((unsigned)(crow(rr, hi) - cs) < 16u) ? s0 : -1e30f; }
        asm volatile("" : "+v"(p0));
#pragma unroll
        for (int rr = 0; rr < 16; ++rr) bv[rr] = rph[crow(rr, hi) + 32];
#pragma unroll
        for (int rr = 0; rr < 16; ++rr) { const float s1 = fmaf(p1[rr], 0.125f, bv[rr]); p1[rr] = ((unsigned)(crow(rr, hi) + 32 - cs) < 16u) ? s1 : -1e30f; } }
      float mn, al; bf16x8 pa0, pa1, pa2, pa3;
      partialSM<true>(p0, p1, m_reg, mn, al);
      if (__any(al < 1.f)) { if (hi == 0) al_l[r32] = al; asm volatile("s_waitcnt lgkmcnt(0)" ::: "memory");
#pragma unroll
        for (int d = 0; d < 2; ++d)
#pragma unroll
          for (int rr = 0; rr < 16; ++rr) o[d][rr] *= al_l[crow(rr, hi)]; }
      finishSM(p0, p1, al, l_reg, pa0, pa1, pa2, pa3); SBAR();
      pv_one64<0>(o[0], vb + so, pa0, pa1, pa2, pa3); pv_one64<1>(o[1], vb + so, pa0, pa1, pa2, pa3);
      }
      { const int i = i2 + 1, so = 65536;
#pragma unroll
        for (int it = 0; it < 4; ++it) { *(bf16x8*)(lds + so + kst + it * 2048) = kr1[it]; *(bf16x8*)(lds + so + vst + it * 2048) = vr1[it]; }
        if (i + 2 < 8) NA_LOAD(kr1, vr1, i + 2);
        __syncthreads();
      f32x16 p0, p1;
#pragma unroll
      for (int rr = 0; rr < 16; ++rr) { p0[rr] = 0.f; p1[rr] = 0.f; }
#pragma unroll
      for (int d0 = 0; d0 < 4; ++d0) {
        const int co = ((d0 * 2 + hi) ^ kx) << 4;
        const bf16x8 b0 = *(const bf16x8*)(K_l + so + krd + co);
        const bf16x8 b1 = *(const bf16x8*)(K_l + so + krd + 4096 + co);
        p0 = MFMA32(b0, qr[d0], p0);
        p1 = MFMA32(b1, qr[d0], p1);
      }
      const float* rph = rp + hp * 465 + (r0 + i - r + 7) * 31 + 15 - c;
      { float bv[16];
#pragma unroll
        for (int rr = 0; rr < 16; ++rr) bv[rr] = rph[crow(rr, hi)];
#pragma unroll
        for (int rr = 0; rr < 16; ++rr) { const float s0 = fmaf(p0[rr], 0.125f, bv[rr]); p0[rr] = ((unsigned)(crow(rr, hi) - cs) < 16u) ? s0 : -1e30f; }
        asm volatile("" : "+v"(p0));
#pragma unroll
        for (int rr = 0; rr < 16; ++rr) bv[rr] = rph[crow(rr, hi) + 32];
#pragma unroll
        for (int rr = 0; rr < 16; ++rr) { const float s1 = fmaf(p1[rr], 0.125f, bv[rr]); p1[rr] = ((unsigned)(crow(rr, hi) + 32 - cs) < 16u) ? s1 : -1e30f; } }
      float mn, al; bf16x8 pa0, pa1, pa2, pa3;
      partialSM<true>(p0, p1, m_reg, mn, al);
      if (__any(al < 1.f)) { if (hi == 0) al_l[r32] = al; asm volatile("s_waitcnt lgkmcnt(0)" ::: "memory");
#pragma unroll
        for (int d = 0; d < 2; ++d)
#pragma unroll
          for (int rr = 0; rr < 16; ++rr) o[d][rr] *= al_l[crow(rr, hi)]; }
      finishSM(p0, p1, al, l_reg, pa0, pa1, pa2, pa3); SBAR();
      pv_one64<0>(o[0], vb + so, pa0, pa1, pa2, pa3); pv_one64<1>(o[1], vb + so, pa0, pa1, pa2, pa3);
      }
    }
#undef NA_LOAD
    if (hi == 0) li_l[r32] = l_reg; asm volatile("s_waitcnt lgkmcnt(0)" ::: "memory");
    u16* Ow = O + (long)(seqbase + r * 64 + m * 32) * 1024 + h * 64 + r32;
#pragma unroll
    for (int rr = 0; rr < 16; ++rr) { const int q = crow(rr, hi); const float il = __builtin_amdgcn_rcpf(li_l[q]);
      Ow[(long)q * 1024] = (u16)(cvtpk(o[0][rr] * il, 0.f) & 0xffffu); Ow[(long)q * 1024 + 32] = (u16)(cvtpk(o[1][rr] * il, 0.f) & 0xffffu); }
  }
}

#define XB_TMO      128
#define XB_XCNT(j)  (256  + 64 * (j))
#define XB_XSUB(j)  (1280 + 64 * (j))
#define XB_XGEN(j)  (2304 + 64 * (j))
#define XB_TOP      3328
#define XB_TOPGEN   3392
#define XCD_BAR_WORDS 3456
#define XB_SPIN_CAP (1u << 18)
DI unsigned xb_ld(unsigned* p)              { return __hip_atomic_load(p, __ATOMIC_RELAXED, __HIP_MEMORY_SCOPE_AGENT); }
DI unsigned xb_add(unsigned* p, unsigned v) { return __hip_atomic_fetch_add(p, v, __ATOMIC_RELAXED, __HIP_MEMORY_SCOPE_AGENT); }
DI unsigned xb_xcc_id() { return (unsigned)__builtin_amdgcn_s_getreg((3 << 11) | 20) & 0xFu; }
#define XB_SPIN(cond, bar) do { unsigned _sp = 0; while (cond) { __builtin_amdgcn_s_sleep(1); \
    if ((++_sp & 255u) == 0u) { if (xb_ld(&(bar)[XB_TMO])) break; if (_sp > XB_SPIN_CAP) { atomicAdd(&(bar)[XB_TMO], 1u); break; } } } } while (0)
struct XcdBarrier { unsigned* bar; unsigned x; volatile __attribute__((address_space(3))) unsigned* st; };
DI void xcd_barrier_complete(unsigned* bar, unsigned x, unsigned& nloc, unsigned& nx) {
  const unsigned G = gridDim.x * gridDim.y * gridDim.z;
  unsigned sum, cnt, mine, sp = 0u;
  for (;;) {
    sum = 0u; cnt = 0u; mine = 0u;
#pragma unroll
    for (unsigned j = 0; j < 16; ++j) { const unsigned c = xb_ld(&bar[XB_XCNT(j)]); sum += c; cnt += (c > 0u) ? 1u : 0u; mine = (j == x) ? c : mine; }
    if (sum == G) break;
    __builtin_amdgcn_s_sleep(1);
    if ((++sp & 255u) == 0u) { if (xb_ld(&bar[XB_TMO])) break; if (sp > XB_SPIN_CAP) { atomicAdd(&bar[XB_TMO], 1u); break; } }
  }
  nloc = mine > 0u ? mine : 1u; nx = cnt > 0u ? cnt : 1u;
}
DI void xcd_barrier(const XcdBarrier& b, int tid) {
  asm volatile("s_waitcnt vmcnt(0)" ::: "memory");
  __syncthreads();
  if (tid == 0) {
    unsigned* bar = b.bar;
    __builtin_amdgcn_s_waitcnt(0);
    unsigned nloc = b.st[0], nx = b.st[1];
    if (nloc == 0u) { xcd_barrier_complete(bar, b.x, nloc, nx); b.st[0] = nloc; b.st[1] = nx; }
    const unsigned old = xb_add(&bar[XB_XSUB(b.x)], 1u);
    const unsigned gen = old / nloc;
    if (old + 1u == (gen + 1u) * nloc) {
      __builtin_amdgcn_fence(__ATOMIC_RELEASE, "agent");
      asm volatile("s_waitcnt vmcnt(0)" ::: "memory");
      const unsigned og = xb_add(&bar[XB_TOP], 1u);
      const unsigned tg = og / nx;
      if (og + 1u == (tg + 1u) * nx) xb_add(&bar[XB_TOPGEN], 1u);
      else XB_SPIN(xb_ld(&bar[XB_TOPGEN]) == tg, bar);
      __builtin_amdgcn_fence(__ATOMIC_ACQUIRE, "agent");
      xb_add(&bar[XB_XGEN(b.x)], 1u);
      asm volatile("s_waitcnt vmcnt(0)" ::: "memory");
    } else {
      XB_SPIN(xb_ld(&bar[XB_XGEN(b.x)]) == gen, bar);
      __builtin_amdgcn_fence(__ATOMIC_ACQUIRE, "agent");
      asm volatile("s_waitcnt vmcnt(0)" ::: "memory");
    }
  }
  __syncthreads();
}

struct EpiArgs { u16* C16; int ldc; float* Cf; const float* R; const float2* rope; int row0; };
enum { K_PRO = 0, K_RMS, K_LAT, K_G_BF16, K_G_QROPE, K_G_RELU2, K_G_RESID, K_G_RESID_ST, K_ATTN, K_NA, K_FINAL };
constexpr int NSTEPS = 32;
__global__ void __launch_bounds__(NTHR) fwd_megakernel(Params p) {
  __shared__ __attribute__((aligned(16))) char lds[LDS_BYTES];
  cg::grid_group grid = cg::this_grid();
#ifdef PROBE_REP_KIND
  int repeated = 0;
#endif
  const int wave_s__ = __builtin_amdgcn_readfirstlane((int)__builtin_amdgcn_workitem_id_x() >> 6);
  XcdBarrier xbar; xbar.bar = (unsigned*)(p.ws + WS_BAR); xbar.x = xb_xcc_id(); xbar.st = (volatile __attribute__((address_space(3))) unsigned*)(lds + LDS_BYTES - 16);
  if (__builtin_amdgcn_workitem_id_x() == 0) { xbar.st[0] = 0u; xbar.st[1] = 0u; (void)xb_add(&xbar.bar[XB_XCNT(xbar.x)], 1u); }
  __syncthreads();
#pragma unroll 1
  for (int ph = 0; ph < NSTEPS; ++ph) {
    int lane__, bid__ = __builtin_amdgcn_workgroup_id_x();
    asm volatile("v_mbcnt_lo_u32_b32 %0, -1, 0\n\tv_mbcnt_hi_u32_b32 %0, -1, %0" : "=v"(lane__));
    int tid__ = wave_s__ * 64 + lane__;
    asm volatile("" : "+v"(tid__), "+s"(bid__));
    char* ws = p.ws;
    int kind = K_FINAL, sync = 1, chunk = 0;
    const u16* gA = nullptr; const u16* gB = nullptr; int lda = 0, gK = 0, gM = 0, gN = 0;
    EpiArgs ea{nullptr, 0, nullptr, nullptr, nullptr, 0};
    u16* eXB = nullptr; float* eSS = (float*)(ws + WS_SS);
    if (ph == 0) { kind = K_PRO; }
    else if (ph == 1) { kind = K_G_BF16; gA = (const u16*)(ws + WS_A); lda = DM; gB = (const u16*)(ws + W_DQKV); gK = 1024; gM = TT; gN = 768; ea.C16 = (u16*)(ws + WS_B); ea.ldc = 768; }
    else if (ph == 2) { kind = K_LAT; }
    else if (ph < 21) {
      const int c = (ph - 3) / 6, sub = (ph - 3) - 6 * c; chunk = c;
      if (sub == 0) { kind = K_G_QROPE; sync = 0; gA = (const u16*)(ws + WS_CQ) + (long)c * CH * 384; lda = 384; gB = (const u16*)(ws + W_UQ); gK = 384; gM = CH; gN = 3072;
                      ea.C16 = (u16*)(ws + WS_A); ea.ldc = 3072; ea.rope = (const float2*)(ws + WS_ROPE); ea.row0 = c * CH; }
      else if (sub == 1) { kind = K_G_BF16; gA = (const u16*)(ws + WS_CKV) + (long)c * CH * 256; lda = 256; gB = (const u16*)(ws + W_UKV); gK = 256; gM = CH; gN = 4096;
                           ea.C16 = (u16*)(ws + WS_D); ea.ldc = 4096; }
      else if (sub == 2) { kind = K_ATTN; }
      else if (sub == 3) { kind = K_G_RESID_ST; gA = (const u16*)(ws + WS_B); lda = 2048; gB = (const u16*)(ws + W_O); gK = 2048; gM = CH; gN = DM;
             ea.ldc = DM; ea.Cf = p.out + (long)c * CH * DM; ea.R = c < 2 ? p.xp + (long)c * CH * DM : p.xs;
             eXB = (u16*)(ws + WS_A); eSS += (long)c * CH; }
      else if (sub == 4) { kind = K_G_RELU2; gA = (const u16*)(ws + WS_A); lda = DM; gB = (const u16*)(ws + W_W1); gK = 1024; gM = CH; gN = 4096;
                           ea.C16 = (u16*)(ws + WS_D); ea.ldc = 4096; eSS += (long)c * CH; }
      else { kind = K_G_RESID; gA = (const u16*)(ws + WS_D); lda = 4096; gB = (const u16*)(ws + W_W2); gK = 4096; gM = CH; gN = DM;
             ea.ldc = DM; ea.Cf = p.out + (long)c * CH * DM; ea.R = ea.Cf; }
    }
    else if (ph == 21) { kind = K_RMS; }
    else if (ph == 22) { kind = K_G_BF16; gA = (const u16*)(ws + WS_H1); lda = DM; gB = (const u16*)(ws + W_NAQKV); gK = 1024; gM = TT; gN = 3072; ea.C16 = (u16*)(ws + WS_NAQKV); ea.ldc = 3072; }
    else if (ph == 23) { kind = K_NA; }
    else if (ph == 24) { kind = K_G_RESID_ST; gA = (const u16*)(ws + WS_H1); lda = DM; gB = (const u16*)(ws + W_NAO); gK = 1024; gM = TT; gN = DM; ea.ldc = DM; ea.Cf = p.out; ea.R = p.out;
                         eXB = (u16*)(ws + WS_A); }
    else if (ph < 31) {
      const int q = ph - 25, c = q >> 1;
      if ((q & 1) == 0) { kind = K_G_RELU2; gA = (const u16*)(ws + WS_A) + (long)c * CH * DM; lda = DM; gB = (const u16*)(ws + W_W1) + (long)4096 * 1024; gK = 1024; gM = CH; gN = 4096;
                          ea.C16 = (u16*)(ws + WS_D); ea.ldc = 4096; eSS += (long)c * CH; }
      else { kind = K_G_RESID; gA = (const u16*)(ws + WS_D); lda = 4096; gB = (const u16*)(ws + W_W2) + (long)4096 * 1024; gK = 4096; gM = CH; gN = DM;
             ea.ldc = DM; ea.Cf = p.out + (long)c * CH * DM; ea.R = ea.Cf; }
    }
    else { kind = K_FINAL; sync = 0; }

    switch (kind) {
      case K_PRO:
        phase_prologue(tid__, bid__, p, lds);
        phase_rmsnorm_bf16(tid__, bid__, p.xp, p.xs, TP, p.attn_norm, (u16*)(ws + WS_A));
        break;
      case K_RMS: phase_rmsnorm_bf16(tid__, bid__, p.out, p.out, TT, p.attn_norm + DM, (u16*)(ws + WS_H1), (float*)(ws + WS_SS)); break;
      case K_LAT: phase_lat_norm(tid__, bid__, (const u16*)(ws + WS_B), p.q_norm, p.kv_norm, (const float2*)(ws + WS_ROPE), (u16*)(ws + WS_CQ), (u16*)(ws + WS_CKV), (u16*)(ws + WS_KR)); break;
      case K_G_BF16: { pg8::Gemm g{gA, gB, gM, gN, gK}; pg8::StaticOrder S; S.init(gM, gN, (int)gridDim.x, bid__); pg8::EpiBf16<0> E{ea.C16, ea.ldc, nullptr};
        pg8::gemm_phase(tid__, (PG8_LAS unsigned char*)lds, g, S, E); } break;
      case K_G_QROPE: { pg8::Gemm g{gA, gB, gM, gN, gK}; pg8::StaticOrder S; S.init(gM, gN, (int)gridDim.x, bid__); pg8::EpiQRope E{ea.C16, ea.ldc, (const float*)ea.rope, ea.row0, ATT_SCALE * 1.4426950408889634f};
        pg8::gemm_phase(tid__, (PG8_LAS unsigned char*)lds, g, S, E); } break;
      case K_G_RELU2: { pg8::Gemm g{gA, gB, gM, gN, gK}; pg8::StaticOrder S; S.init(gM, gN, (int)gridDim.x, bid__); pg8::EpiBf16<1> E{ea.C16, ea.ldc, eSS};
        pg8::gemm_phase(tid__, (PG8_LAS unsigned char*)lds, g, S, E); } break;
      case K_G_RESID: { pg8::Gemm g{gA, gB, gM, gN, gK}; pg8::StaticOrder S; S.init(gM, gN, (int)gridDim.x, bid__); pg8::EpiResid<false> E{ea.Cf, ea.R, ea.ldc, nullptr, nullptr};
        pg8::gemm_phase(tid__, (PG8_LAS unsigned char*)lds, g, S, E); } break;
      case K_G_RESID_ST: { pg8::Gemm g{gA, gB, gM, gN, gK}; pg8::StaticOrder S; S.init(gM, gN, (int)gridDim.x, bid__); pg8::EpiResid<true> E{ea.Cf, ea.R, ea.ldc, eXB, eSS};
        pg8::gemm_phase(tid__, (PG8_LAS unsigned char*)lds, g, S, E); } break;
      case K_ATTN:
        phase_attn(tid__, bid__, (const u16*)(ws + WS_A), (const u16*)(ws + WS_D), (const u16*)(ws + WS_KR) + (long)chunk * CH * 64, (u16*)(ws + WS_B), chunk, lds); break;
      case K_NA:
        phase_na(tid__, bid__, (const u16*)(ws + WS_NAQKV), p.na_rpb, (u16*)(ws + WS_H1), lds); break;
      default: phase_rmsnorm_final(tid__, bid__, p.out, p.final_norm); break;
    }
    if (sync) { if (gridDim.x == 0u) grid.sync();   xcd_barrier(xbar, tid__); }
#ifdef PROBE_REP_KIND
    if (kind == PROBE_REP_KIND && !repeated) { repeated = 1; --ph; } else repeated = 0;
#endif
  }
}

extern "C" void kernel_launch(void* const* d_in, const int* in_sizes, int n_in, void* d_out, int out_size, void* d_ws, size_t ws_size, hipStream_t stream) {
  static int grid_blocks = 0;
  if (!grid_blocks) {
    int dev = 0, cus = 0, per_cu = 0;
    hipGetDevice(&dev);
    hipDeviceGetAttribute(&cus, hipDeviceAttributeMultiprocessorCount, dev);
    hipOccupancyMaxActiveBlocksPerMultiprocessor(&per_cu, fwd_megakernel, NTHR, 0);
    if (per_cu != 1) per_cu = 1;
    grid_blocks = cus * per_cu;
    if (ws_size < WS_END) fprintf(stderr, "kernel_launch: workspace too small: %zu < %zu\n", ws_size, (size_t)WS_END);
  }
  Params p{};
  p.xp = (const float*)d_in[0]; p.xs = (const float*)d_in[1]; p.attn_norm = (const float*)d_in[2]; p.mlp_norm = (const float*)d_in[3];
  p.final_norm = (const float*)d_in[4]; p.w_dq = (const float*)d_in[5]; p.q_norm = (const float*)d_in[6]; p.w_uq = (const float*)d_in[7];
  p.w_dkv = (const float*)d_in[8]; p.kv_norm = (const float*)d_in[9]; p.w_ukv = (const float*)d_in[10]; p.w_o = (const float*)d_in[11];
  p.na_w_qkv = (const float*)d_in[12]; p.na_rpb = (const float*)d_in[13]; p.na_w_o = (const float*)d_in[14]; p.w1 = (const float*)d_in[15];
  p.w2 = (const float*)d_in[16]; p.out = (float*)d_out; p.ws = (char*)d_ws;
  (void)hipMemsetAsync((char*)d_ws + WS_BAR, 0, XCD_BAR_WORDS * 4, stream);
  void* args[] = {&p};
  hipError_t e = hipLaunchCooperativeKernel((void*)fwd_megakernel, dim3(grid_blocks), dim3(NTHR), args, 0, stream);
  if (e != hipSuccess) fprintf(stderr, "cooperative launch failed: %s (grid %d)\n", hipGetErrorString(e), grid_blocks);
}
```
